# Optimizing an MI355X kernel written in HIP

```python
import jax
import jax.numpy as jnp
from jax import lax
import numpy as np

D_MODEL = 1024
BATCH = 8
SEQ = 2048
DEPTH = 1

GRID_W = 64
HEAD_DIM = 64
NA_HEADS = 8
NA_WIN_H = 8
NA_WIN_W = 16
GQA_HEADS = 8
GQA_KV_HEADS = 2
Q_BLOCK = 128
ROPE_THETA = 10000.0
PEER_HEADS = 8
PEER_NKEYS = 128
PEER_EXPERTS = PEER_NKEYS * PEER_NKEYS
PEER_QDIM = 256
PEER_HALF = PEER_QDIM // 2
PEER_TOPK = 16
PEER_CHUNK = 128
EPS = 1e-6

NA_WIDTH = NA_HEADS * HEAD_DIM
GQA_Q_WIDTH = GQA_HEADS * HEAD_DIM
GQA_KV_WIDTH = GQA_KV_HEADS * HEAD_DIM
IN_SPLITS = (NA_WIDTH, NA_WIDTH, NA_WIDTH, GQA_Q_WIDTH, GQA_KV_WIDTH, GQA_KV_WIDTH, D_MODEL, D_MODEL)
IN_WIDTH = sum(IN_SPLITS)
IN_SPLIT_POINTS = tuple(int(p) for p in np.cumsum(IN_SPLITS)[:-1])

kernel_name = "hybrid_natten_gqa_peer_encoder"


def rmsnorm(x, g):
    xf = x.astype(jnp.float32)
    y = xf * lax.rsqrt(jnp.mean(xf * xf, axis=-1, keepdims=True) + EPS)
    return (y * g.astype(jnp.float32)).astype(x.dtype)


def neighbourhood_attention(q, k, v, rpb):
    b, s, h, dh = q.shape
    rows = s // GRID_W
    kh = min(NA_WIN_H, rows)
    q = q.reshape(b, rows, GRID_W, h, dh)
    k = k.reshape(b, rows, GRID_W, h, dh)
    v = v.reshape(b, rows, GRID_W, h, dh)
    r = jnp.arange(rows)
    row_start = jnp.clip(r - kh // 2, 0, rows - kh)
    key_rows = row_start[:, None] + jnp.arange(kh)[None, :]
    k_g = k[:, key_rows]
    v_g = v[:, key_rows]
    c = jnp.arange(GRID_W)
    col_start = jnp.clip(c - NA_WIN_W // 2, 0, GRID_W - NA_WIN_W)
    in_win = (c[None, :] >= col_start[:, None]) & (c[None, :] < col_start[:, None] + NA_WIN_W)
    dr = key_rows - r[:, None] + (NA_WIN_H - 1)
    dc = jnp.clip(c[None, :] - c[:, None], -(NA_WIN_W - 1), NA_WIN_W - 1) + (NA_WIN_W - 1)
    bias = rpb[:, dr[:, None, :, None], dc[None, :, None, :]].astype(jnp.float32)
    scores = jnp.einsum("brqhd,brkwhd->bhrqkw", q, k_g).astype(jnp.float32) * (dh ** -0.5) + bias[None]
    scores = jnp.where(in_win[:, None, :], scores, -jnp.inf)
    probs = jax.nn.softmax(scores.reshape(b, h, rows, GRID_W, kh * GRID_W), axis=-1)
    probs = probs.reshape(b, h, rows, GRID_W, kh, GRID_W).astype(v.dtype)
    out = jnp.einsum("bhrqkw,brkwhd->brqhd", probs, v_g)
    return out.reshape(b, s, h * dh)


def _rotate(x, ang):
    half = x.shape[-1] // 2
    x1, x2 = x[..., :half], x[..., half:]
    cos = jnp.cos(ang)[None, :, None, :]
    sin = jnp.sin(ang)[None, :, None, :]
    return jnp.concatenate([x1 * cos - x2 * sin, x2 * cos + x1 * sin], axis=-1)


def axial_rope(x):
    b, s, h, dh = x.shape
    sec = dh // 2
    nf = sec // 2
    t = jnp.arange(s)
    inv = ROPE_THETA ** (-jnp.arange(nf, dtype=jnp.float32) / nf)
    ang_r = (t // GRID_W).astype(jnp.float32)[:, None] * inv[None, :]
    ang_c = (t % GRID_W).astype(jnp.float32)[:, None] * inv[None, :]
    xf = x.astype(jnp.float32)
    out = jnp.concatenate([_rotate(xf[..., :sec], ang_r), _rotate(xf[..., sec:], ang_c)], axis=-1)
    return out.astype(x.dtype)


def gqa_attention(q, k, v):
    b, s, h, dh = q.shape
    hkv = k.shape[2]
    grp = h // hkv
    nblk = s // Q_BLOCK
    qb = q.reshape(b, nblk, Q_BLOCK, hkv, grp, dh).transpose(1, 0, 2, 3, 4, 5)
    scale = dh ** -0.5

    def block(qblk):
        sc = jnp.einsum("bqngd,bknd->bngqk", qblk, k).astype(jnp.float32) * scale
        p = jax.nn.softmax(sc, axis=-1).astype(v.dtype)
        return jnp.einsum("bngqk,bknd->bqngd", p, v)

    out = lax.map(block, qb)
    return out.transpose(1, 0, 2, 3, 4, 5).reshape(b, s, h * dh)


def peer(xn, w_q, sub_keys, u, v):
    b, s, d = xn.shape
    t = b * s
    xt = xn.reshape(t, d)
    q = (xt @ w_q).reshape(t, PEER_HEADS, 2, PEER_HALF)
    sc = jnp.einsum("thpc,hpnc->thpn", q, sub_keys).astype(jnp.float32)
    top_s, top_i = lax.top_k(sc, PEER_TOPK)
    cand_s = (top_s[:, :, 0, :, None] + top_s[:, :, 1, None, :]).reshape(t, PEER_HEADS, PEER_TOPK * PEER_TOPK)
    cand_i = (top_i[:, :, 0, :, None] * PEER_NKEYS + top_i[:, :, 1, None, :]).reshape(t, PEER_HEADS, PEER_TOPK * PEER_TOPK)
    best_s, best_pos = lax.top_k(cand_s, PEER_TOPK)
    idx = jnp.take_along_axis(cand_i, best_pos, axis=-1)
    gate = jax.nn.softmax(best_s, axis=-1)
    nchunk = t // PEER_CHUNK
    x_c = xt.reshape(nchunk, PEER_CHUNK, d)
    i_c = idx.reshape(nchunk, PEER_CHUNK, PEER_HEADS * PEER_TOPK)
    g_c = gate.reshape(nchunk, PEER_CHUNK, PEER_HEADS * PEER_TOPK)

    def chunk(args):
        xc, ic, gc = args
        uc = u[ic]
        act = jnp.einsum("cd,ced->ce", xc, uc).astype(jnp.float32)
        hid = (jax.nn.gelu(act, approximate=False) * gc).astype(xc.dtype)
        return jnp.einsum("ce,ced->cd", hid, v[ic])

    out = lax.map(chunk, (x_c, i_c, g_c))
    return out.reshape(b, s, d)


def setup_inputs(seed: int = 0) -> dict:
    key = jax.random.key(seed)
    ks = jax.random.split(key, 16)
    f32 = jnp.float32
    nrm = lambda k, shape, scale: jax.random.normal(k, shape, f32) * scale
    return {
        "x": nrm(ks[0], (BATCH, SEQ, D_MODEL), 1.0),
        "norm1_g": 1.0 + nrm(ks[1], (DEPTH, D_MODEL), 0.1),
        "w_in": nrm(ks[2], (DEPTH, D_MODEL, IN_WIDTH), D_MODEL ** -0.5),
        "na_rpb": nrm(ks[3], (DEPTH, NA_HEADS, 2 * NA_WIN_H - 1, 2 * NA_WIN_W - 1), 0.5),
        "gqa_q_norm_g": 1.0 + nrm(ks[4], (DEPTH, HEAD_DIM), 0.1),
        "gqa_k_norm_g": 1.0 + nrm(ks[5], (DEPTH, HEAD_DIM), 0.1),
        "w_proj_a": nrm(ks[6], (DEPTH, NA_WIDTH, D_MODEL), NA_WIDTH ** -0.5),
        "w_proj_b": nrm(ks[7], (DEPTH, GQA_Q_WIDTH, D_MODEL), GQA_Q_WIDTH ** -0.5),
        "w_out": nrm(ks[8], (DEPTH, D_MODEL, D_MODEL), D_MODEL ** -0.5),
        "norm2_g": 1.0 + nrm(ks[9], (DEPTH, D_MODEL), 0.1),
        "peer_w_q": nrm(ks[10], (DEPTH, D_MODEL, PEER_HEADS * PEER_QDIM), D_MODEL ** -0.5),
        "peer_sub_keys": nrm(ks[11], (DEPTH, PEER_HEADS, 2, PEER_NKEYS, PEER_HALF), PEER_HALF ** -0.5),
        "peer_u": nrm(ks[12], (DEPTH, PEER_EXPERTS, D_MODEL), D_MODEL ** -0.5),
        "peer_v": nrm(ks[13], (DEPTH, PEER_EXPERTS, D_MODEL), PEER_HEADS ** -0.5),
        "norm_f_g": 1.0 + nrm(ks[14], (D_MODEL,), 0.1),
    }


def reference(x, norm1_g, w_in, na_rpb, gqa_q_norm_g, gqa_k_norm_g, w_proj_a, w_proj_b, w_out,
              norm2_g, peer_w_q, peer_sub_keys, peer_u, peer_v, norm_f_g):
    b, s, _ = x.shape
    for l in range(DEPTH):
        h = rmsnorm(x, norm1_g[l])
        proj = h @ w_in[l]
        qa, ka, va, qb, kb, vb, ga, gb = jnp.split(proj, IN_SPLIT_POINTS, axis=-1)
        ya = neighbourhood_attention(
            qa.reshape(b, s, NA_HEADS, HEAD_DIM),
            ka.reshape(b, s, NA_HEADS, HEAD_DIM),
            va.reshape(b, s, NA_HEADS, HEAD_DIM),
            na_rpb[l])
        qh = axial_rope(rmsnorm(qb.reshape(b, s, GQA_HEADS, HEAD_DIM), gqa_q_norm_g[l]))
        kh = axial_rope(rmsnorm(kb.reshape(b, s, GQA_KV_HEADS, HEAD_DIM), gqa_k_norm_g[l]))
        yb = gqa_attention(qh, kh, vb.reshape(b, s, GQA_KV_HEADS, HEAD_DIM))
        merged = jax.nn.sigmoid(ga) * (ya @ w_proj_a[l]) + jax.nn.sigmoid(gb) * (yb @ w_proj_b[l])
        x = x + merged @ w_out[l]
        x = x + peer(rmsnorm(x, norm2_g[l]), peer_w_q[l], peer_sub_keys[l], peer_u[l], peer_v[l])
    return rmsnorm(x, norm_f_g)
```

```cpp
#include <hip/hip_runtime.h>
#include <cstdio>
#include <cstdint>
constexpr int T = 16384, D = 1024, SEQ = 2048, INW = 4352, NEXP = 16384;
constexpr float EPS = 1e-6f;
constexpr size_t MiB = 1u << 20;
constexpr size_t WS_CTL = 0, CTL_ZERO_BYTES = 1 * MiB;
constexpr size_t WS_TAB = 1 * MiB;
constexpr size_t WS_SUBK = 1 * MiB + 65536;
constexpr size_t WS_WIN = 2 * MiB, WS_WA = 11 * MiB, WS_WB = 12 * MiB, WS_WOUT = 13 * MiB, WS_WQ = 15 * MiB;
constexpr size_t WS_U = 20 * MiB, WS_V = 52 * MiB;
constexpr size_t WS_H = 84 * MiB;
constexpr size_t WS_QA = 116 * MiB, WS_KA = 132 * MiB, WS_VA = 148 * MiB;
constexpr size_t WS_QB = 164 * MiB, WS_KB = 180 * MiB, WS_VB = 184 * MiB;
constexpr size_t WS_G = 188 * MiB;
constexpr size_t WS_XN = WS_KA, WS_IDX = WS_QB, WS_GATE = WS_QB + 8 * MiB, WS_Q2 = WS_G, WS_MERGED = WS_H;
constexpr size_t WS_END = 252 * MiB;
constexpr int CW_BAR = 4096;
namespace pg8 {
#define PG8_LAS __attribute__((address_space(3)))
typedef unsigned short bf16_t;
typedef short bf16x8 __attribute__((ext_vector_type(8)));
typedef float f32x4 __attribute__((ext_vector_type(4)));
typedef unsigned u32x4 __attribute__((ext_vector_type(4)));
constexpr int BM = 256, BK = 64, HALF = 128, HTB = HALF * BK * 2  , STAGE_BYTES = 8 * HTB, NXCD = 8, WGM = 8;

__host__ __device__ __forceinline__ int lds_byte(int r, int c) { const int st = (r >> 4) * 2 + (c >> 5), rr = r & 15, cc = c & 31, ob = rr * 64 + cc * 2; return st * 1024 + (ob ^ (((ob >> 9) & 1) << 5)); }
__host__ __device__ __forceinline__ void stage_rc(int b, int& R, int& C) { const int st = b / 1024, sb = b % 1024, swz = sb ^ (((sb >> 9) & 1) << 5); R = (st >> 1) * 16 + swz / 64; C = (st & 1) * 32 + (swz % 64) / 2; }
__host__ __device__ __forceinline__ int perm32(int rho) { const int n = rho >> 4, i = rho & 15; return 8 * (i >> 2) + 4 * n + (i & 3); }

struct Unit { int pm, pn; };
struct Gemm { const bf16_t* A; const bf16_t* Bt; int M, N, K; };

struct StaticOrder {
    int nM, nN, nwg, G, c;
    __host__ __device__ void init(int M, int N, int G_, int c_) { nM = M / BM; nN = N / BM; nwg = nM * nN; G = G_; c = c_; }
    __host__ __device__ bool next(int i, Unit& u) const {
        const long L = (long)i * G + c; if (L >= nwg) return false;
        int wgid = (int)L; { const int q = nwg / NXCD, r = nwg % NXCD, xcd = wgid % NXCD, off = wgid / NXCD; wgid = (xcd < r ? xcd * (q + 1) : r * (q + 1) + (xcd - r) * q) + off; }
        const int nig = WGM * nN, gid = wgid / nig, fm = gid * WGM, gsz = (nM - fm) < WGM ? (nM - fm) : WGM;
        u.pm = fm + ((wgid % nig) % gsz); u.pn = (wgid % nig) / gsz; return true;
    }
    __device__ __forceinline__ void a_ready(const Unit&) const {}
    __device__ __forceinline__ void done(const Unit&) const {}
};
#define PG8_GAS __attribute__((address_space(1)))
__device__ __forceinline__ unsigned cvt_pk_bf16(float lo, float hi) { unsigned r; asm volatile("v_cvt_pk_bf16_f32 %0, %1, %2" : "=v"(r) : "v"(lo), "v"(hi)); return r; }
typedef unsigned u32x2 __attribute__((ext_vector_type(2)));
__device__ __forceinline__ float bf_lo(unsigned w) { return __builtin_bit_cast(float, w << 16); }
__device__ __forceinline__ float bf_hi(unsigned w) { return __builtin_bit_cast(float, w & 0xffff0000u); }
__device__ __forceinline__ float sigm(float v) { return __builtin_amdgcn_rcpf(1.0f + __builtin_amdgcn_exp2f(-1.4426950408889634f * v)); }
constexpr float QC2 = 0.125f * 1.4426950408889634f;

struct EpiProj {
    static constexpr bool PERM = false, AFTER_DRAIN = false;
    PG8_GAS unsigned char* ws;
    __device__ __forceinline__ void operator()(const f32x4 (&acc)[2][2][4][2], const Unit& u, int wr, int wc, int fr, int fq) const {
        const int pn = u.pn, row0 = u.pm * BM + wr * 64 + fr;
        if (pn < 6 || pn >= 9) {
            size_t boff; int pitch, col; float sc = 1.f; const bool sig = pn >= 9;
            if (pn < 6) { boff = WS_QA + (size_t)(pn >> 1) * (WS_KA - WS_QA); pitch = 512; col = (pn & 1) * 256; sc = pn < 2 ? QC2 : 1.f; }
            else { boff = WS_G; pitch = 2048; col = (pn - 9) * 256; }
            PG8_GAS bf16_t* base = (PG8_GAS bf16_t*)(ws + boff);
            col += wc * 32 + 8 * fq;
#pragma unroll
            for (int ai = 0; ai < 2; ++ai)
#pragma unroll
                for (int m = 0; m < 4; ++m) { PG8_GAS bf16_t* rowp = base + (size_t)(row0 + ai * HALF + m * 16) * pitch + col;
#pragma unroll
                    for (int bj = 0; bj < 2; ++bj) { f32x4 v0 = acc[ai][bj][m][0], v1 = acc[ai][bj][m][1];
                        if (sig) { v0 = (f32x4){sigm(v0[0]), sigm(v0[1]), sigm(v0[2]), sigm(v0[3])}; v1 = (f32x4){sigm(v1[0]), sigm(v1[1]), sigm(v1[2]), sigm(v1[3])}; }
                        else { v0 = v0 * sc; v1 = v1 * sc; }
                        u32x4 w; w.x = cvt_pk_bf16(v0[0], v0[1]); w.y = cvt_pk_bf16(v0[2], v0[3]); w.z = cvt_pk_bf16(v1[0], v1[1]); w.w = cvt_pk_bf16(v1[2], v1[3]);
                        *(PG8_GAS u32x4*)(rowp + bj * HALF) = w; } }
        } else {
            size_t boff; int pitch, hcol, goff; bool norm; float sc;
            if (pn < 8) { boff = WS_QB; pitch = 512; hcol = ((pn - 6) * 4 + wc) * 64; norm = true; goff = 2048; sc = QC2; }
            else if (wc < 2) { boff = WS_KB; pitch = 128; hcol = wc * 64; norm = true; goff = 2048 + 64; sc = 1.f; }
            else { boff = WS_VB; pitch = 128; hcol = (wc - 2) * 64; norm = false; goff = 2048; sc = 1.f; }
            PG8_GAS bf16_t* base = (PG8_GAS bf16_t*)(ws + boff);
            const PG8_GAS float* tab = (const PG8_GAS float*)(ws + WS_TAB); const PG8_GAS float* g = tab + goff;
#pragma unroll
            for (int ai = 0; ai < 2; ++ai)
#pragma unroll
                for (int m = 0; m < 4; ++m) { const int row = row0 + ai * HALF + m * 16; PG8_GAS bf16_t* rowp = base + (size_t)row * pitch + hcol + 4 * fq;
                    if (norm) {
                        float ss = 0.f;
#pragma unroll
                        for (int bj = 0; bj < 2; ++bj)
#pragma unroll
                            for (int n = 0; n < 2; ++n) { const f32x4 x = acc[ai][bj][m][n]; ss += (x[0] * x[0] + x[1] * x[1]) + (x[2] * x[2] + x[3] * x[3]); }
                        ss += __shfl_xor(ss, 16); ss += __shfl_xor(ss, 32);
                        const float r = __builtin_amdgcn_rsqf(ss * (1.0f / 64.0f) + 1e-6f) ;
                        const int s = row & 2047;
#pragma unroll
                        for (int bj = 0; bj < 2; ++bj) { const int pos = bj ? (s & 63) : (s >> 6);
                            const f32x4 cs = *(const PG8_GAS f32x4*)(tab + pos * 16 + 4 * fq), sn = *(const PG8_GAS f32x4*)(tab + 1024 + pos * 16 + 4 * fq);
                            const f32x4 g0 = *(const PG8_GAS f32x4*)(g + 32 * bj + 4 * fq), g1 = *(const PG8_GAS f32x4*)(g + 32 * bj + 16 + 4 * fq);
                            const f32x4 y0 = acc[ai][bj][m][0] * r * g0, y1 = acc[ai][bj][m][1] * r * g1;
                            const f32x4 o0 = (y0 * cs - y1 * sn) * sc, o1 = (y1 * cs + y0 * sn) * sc;
                            u32x2 w0, w1; w0.x = cvt_pk_bf16(o0[0], o0[1]); w0.y = cvt_pk_bf16(o0[2], o0[3]); w1.x = cvt_pk_bf16(o1[0], o1[1]); w1.y = cvt_pk_bf16(o1[2], o1[3]);
                            *(PG8_GAS u32x2*)(rowp + 32 * bj) = w0; *(PG8_GAS u32x2*)(rowp + 32 * bj + 16) = w1; }
                    } else {
#pragma unroll
                        for (int bj = 0; bj < 2; ++bj)
#pragma unroll
                            for (int n = 0; n < 2; ++n) { const f32x4 x = acc[ai][bj][m][n]; u32x2 w; w.x = cvt_pk_bf16(x[0], x[1]); w.y = cvt_pk_bf16(x[2], x[3]); *(PG8_GAS u32x2*)(rowp + 32 * bj + 16 * n) = w; }
                    } }
        }
    }
};
template <int MODE> struct EpiGate {
    static constexpr bool PERM = false, AFTER_DRAIN = false;
    const PG8_GAS bf16_t* SG; int gcol0; PG8_GAS bf16_t* Mg;
    __device__ __forceinline__ void operator()(const f32x4 (&acc)[2][2][4][2], const Unit& u, int wr, int wc, int fr, int fq) const {
        const int row0 = u.pm * BM + wr * 64 + fr, col = u.pn * BM + wc * 32 + 8 * fq;
#pragma unroll
        for (int ai = 0; ai < 2; ++ai)
#pragma unroll
            for (int m = 0; m < 4; ++m) { const size_t row = (size_t)(row0 + ai * HALF + m * 16);
#pragma unroll
                for (int bj = 0; bj < 2; ++bj) { const int c = col + bj * HALF;
                    const u32x4 gw = *(const PG8_GAS u32x4*)(SG + row * 2048 + gcol0 + c);
                    f32x4 v0 = acc[ai][bj][m][0], v1 = acc[ai][bj][m][1];
                    v0 = v0 * (f32x4){bf_lo(gw.x), bf_hi(gw.x), bf_lo(gw.y), bf_hi(gw.y)}; v1 = v1 * (f32x4){bf_lo(gw.z), bf_hi(gw.z), bf_lo(gw.w), bf_hi(gw.w)};
                    PG8_GAS u32x4* dst = (PG8_GAS u32x4*)(Mg + row * 1024 + c);
                    if (MODE == 1) { const u32x4 ow = *dst; v0 = v0 + (f32x4){bf_lo(ow.x), bf_hi(ow.x), bf_lo(ow.y), bf_hi(ow.y)}; v1 = v1 + (f32x4){bf_lo(ow.z), bf_hi(ow.z), bf_lo(ow.w), bf_hi(ow.w)}; }
                    u32x4 w; w.x = cvt_pk_bf16(v0[0], v0[1]); w.y = cvt_pk_bf16(v0[2], v0[3]); w.z = cvt_pk_bf16(v1[0], v1[1]); w.w = cvt_pk_bf16(v1[2], v1[3]);
                    *dst = w; } }
    }
};
struct EpiRes {
    static constexpr bool PERM = false, AFTER_DRAIN = false;
    const PG8_GAS float* base; PG8_GAS float* out;
    __device__ __forceinline__ void operator()(const f32x4 (&acc)[2][2][4][2], const Unit& u, int wr, int wc, int fr, int fq) const {
        const int row0 = u.pm * BM + wr * 64 + fr, col = u.pn * BM + wc * 32 + 4 * fq;
#pragma unroll
        for (int ai = 0; ai < 2; ++ai)
#pragma unroll
            for (int m = 0; m < 4; ++m) { const size_t off = (size_t)(row0 + ai * HALF + m * 16) * 1024 + col;
#pragma unroll
                for (int bj = 0; bj < 2; ++bj)
#pragma unroll
                    for (int n = 0; n < 2; ++n) { const f32x4 b = *(const PG8_GAS f32x4*)(base + off + bj * HALF + n * 16); *(PG8_GAS f32x4*)(out + off + bj * HALF + n * 16) = b + acc[ai][bj][m][n]; } }
    }
};
struct EpiStore {
    static constexpr bool PERM = false, AFTER_DRAIN = false;
    PG8_GAS bf16_t* O; int ldc;
    __device__ __forceinline__ void operator()(const f32x4 (&acc)[2][2][4][2], const Unit& u, int wr, int wc, int fr, int fq) const {
        const int row0 = u.pm * BM + wr * 64 + fr, col = u.pn * BM + wc * 32 + 8 * fq;
#pragma unroll
        for (int ai = 0; ai < 2; ++ai)
#pragma unroll
            for (int m = 0; m < 4; ++m) { PG8_GAS bf16_t* rowp = O + (size_t)(row0 + ai * HALF + m * 16) * ldc + col;
#pragma unroll
                for (int bj = 0; bj < 2; ++bj) { const f32x4 v0 = acc[ai][bj][m][0], v1 = acc[ai][bj][m][1];
                    u32x4 w; w.x = cvt_pk_bf16(v0[0], v0[1]); w.y = cvt_pk_bf16(v0[2], v0[3]); w.z = cvt_pk_bf16(v1[0], v1[1]); w.w = cvt_pk_bf16(v1[2], v1[3]);
                    *(PG8_GAS u32x4*)(rowp + bj * HALF) = w; } }
    }
};

template <class Epi, class Sched, bool ALIGN_EPI = false, bool SP2 = false>
__device__ __forceinline__ void gemm_phase(PG8_LAS unsigned char* lds, const Gemm g, const Sched& S, const Epi& E) {
    int tid_ = threadIdx.x; asm volatile("" : "+v"(tid_));
    const int tid = tid_, wid = __builtin_amdgcn_readfirstlane(tid >> 6), lane = tid & 63, wr = wid >> 2, wc = wid & 3, fr = lane & 15, fq = lane >> 4;
    const int K = g.K, nt = K / BK;
    unsigned voffA[2], voffB[2];
#pragma unroll
    for (int i = 0; i < 2; ++i) { int R, C; stage_rc(tid * 16 + i * 8192, R, C); const int Rb = Epi::PERM ? ((R & ~31) + perm32(R & 31)) : R;
        voffA[i] = (unsigned)(R * K + C) * 2u; voffB[i] = (unsigned)(Rb * K + C) * 2u; }
    const size_t kstep = (size_t)(BK * 2);
    const size_t hstep = (size_t)HALF * K * 2;
    const size_t tstep = 2 * hstep;
    const unsigned ldsw = (unsigned)wid * 1024u;
    const int aoff = lds_byte(wr * 64 + fr, fq * 8), boff = lds_byte(wc * 32 + fr, fq * 8);
#define PG8_SA(b, h) (((b) * 2 + (h)) * HTB)
#define PG8_SB(b, h) ((4 + (b) * 2 + (h)) * HTB)
#define PG8_STAGE(bufoff, gbase, voff) do { _Pragma("unroll") for (int _i = 0; _i < 2; ++_i) \
        __builtin_amdgcn_global_load_lds((const unsigned*)((const char*)(gbase) + (voff)[_i]), (PG8_LAS unsigned*)(lds + (bufoff) + ldsw + _i * 8192), 16, 0, 0); } while (0)
#define PG8_LDA(dst, b, h) do { _Pragma("unroll") for (int m = 0; m < 4; ++m) _Pragma("unroll") for (int k = 0; k < 2; ++k) dst[m][k] = *(const PG8_LAS bf16x8*)(lds + PG8_SA(b, h) + aoff + m * 2048 + k * 1024); } while (0)
#define PG8_LDB(dst, b, h) do { _Pragma("unroll") for (int n = 0; n < 2; ++n) _Pragma("unroll") for (int k = 0; k < 2; ++k) dst[n][k] = *(const PG8_LAS bf16x8*)(lds + PG8_SB(b, h) + boff + n * 2048 + k * 1024); } while (0)
#define PG8_MMA(ai, bj, At, Bt) do { __builtin_amdgcn_s_setprio(1); _Pragma("unroll") for (int m = 0; m < 4; ++m) _Pragma("unroll") for (int n = 0; n < 2; ++n) _Pragma("unroll") for (int k = 0; k < 2; ++k) \
        acc[ai][bj][m][n] = __builtin_amdgcn_mfma_f32_16x16x32_bf16(Bt[n][k], At[m][k], acc[ai][bj][m][n], 0, 0, 0); __builtin_amdgcn_s_setprio(0); } while (0)
#define PG8_WAIT_V(n) asm volatile("s_waitcnt vmcnt(" #n ")" ::: "memory")
#define PG8_WAIT_L(n) asm volatile("s_waitcnt lgkmcnt(" #n ")" ::: "memory")
#define PG8_BAR __builtin_amdgcn_s_barrier()
#define PG8_SCHED __builtin_amdgcn_sched_barrier(0)
    Unit cur, nxt; int ui = 0;
    if (!S.next(0, cur)) return;
    f32x4 acc[2][2][4][2];
#pragma unroll
    for (int a = 0; a < 2; ++a)
#pragma unroll
        for (int b = 0; b < 2; ++b)
#pragma unroll
            for (int m = 0; m < 4; ++m)
#pragma unroll
                for (int n = 0; n < 2; ++n) acc[a][b][m][n] = (f32x4){0.f, 0.f, 0.f, 0.f};
    bf16x8 At[4][2], B0[2][2], B1[2][2];
    const char* cA = (const char*)g.A + (size_t)cur.pm * tstep; const char* cB = (const char*)g.Bt + (size_t)cur.pn * tstep;
    S.a_ready(cur);
    if constexpr (SP2) {
        PG8_STAGE(PG8_SB(0, 0), cB, voffB); PG8_STAGE(PG8_SB(0, 1), cB + hstep, voffB); PG8_STAGE(PG8_SA(0, 0), cA, voffA); PG8_STAGE(PG8_SA(0, 1), cA + hstep, voffA);
        if (wr == 1) PG8_BAR;
        PG8_WAIT_V(2); PG8_BAR;
        PG8_STAGE(PG8_SB(1, 0), cB + kstep, voffB); PG8_STAGE(PG8_SA(1, 0), cA + kstep, voffA); PG8_STAGE(PG8_SB(1, 1), cB + hstep + kstep, voffB);
        PG8_WAIT_V(6); PG8_BAR;
    } else {
        PG8_STAGE(PG8_SB(0, 0), cB, voffB); PG8_STAGE(PG8_SA(0, 0), cA, voffA); PG8_STAGE(PG8_SB(0, 1), cB + hstep, voffB); PG8_STAGE(PG8_SA(0, 1), cA + hstep, voffA);
        if (wr == 1) PG8_BAR;
        PG8_WAIT_V(4); PG8_BAR;
        PG8_STAGE(PG8_SB(1, 0), cB + kstep, voffB); PG8_STAGE(PG8_SA(1, 0), cA + kstep, voffA); PG8_STAGE(PG8_SB(1, 1), cB + hstep + kstep, voffB);
        PG8_WAIT_V(6); PG8_BAR;
    }
    for (;;) {
        const bool has_next = S.next(ui + 1, nxt);
        const char* nA = has_next ? (const char*)g.A + (size_t)nxt.pm * tstep : cA; const char* nB = has_next ? (const char*)g.Bt + (size_t)nxt.pn * tstep : cB;
        for (int t = 0; t < nt; t += 2) {
            const bool last = (t == nt - 2);
            const char* a1 = cA + (size_t)(t + 1) * kstep;
            const char* a2 = last ? nA : cA + (size_t)(t + 2) * kstep; const char* b2 = last ? nB : cB + (size_t)(t + 2) * kstep;
            const char* a3 = a2 + kstep; const char* b3 = b2 + kstep;
            if (last && has_next) S.a_ready(nxt);
            if constexpr (SP2) {
            PG8_LDB(B0, 0, 0); PG8_LDB(B1, 0, 1); PG8_SCHED; PG8_LDA(At, 0, 0); PG8_STAGE(PG8_SA(1, 1), a1 + hstep, voffA);
            PG8_WAIT_V(8); PG8_WAIT_L(0); PG8_BAR; PG8_MMA(0, 0, At, B0); PG8_MMA(0, 1, At, B1); PG8_BAR; PG8_SCHED;
            PG8_LDA(At, 0, 1); PG8_STAGE(PG8_SB(0, 0), b2, voffB); PG8_STAGE(PG8_SB(0, 1), b2 + hstep, voffB); PG8_STAGE(PG8_SA(0, 0), a2, voffA);
            PG8_WAIT_V(8); PG8_WAIT_L(0); PG8_BAR; PG8_MMA(1, 0, At, B0); PG8_MMA(1, 1, At, B1); PG8_BAR; PG8_SCHED;
            PG8_LDB(B0, 1, 0); PG8_LDB(B1, 1, 1); PG8_SCHED; PG8_LDA(At, 1, 0); PG8_STAGE(PG8_SA(0, 1), a2 + hstep, voffA);
            PG8_WAIT_V(8); PG8_WAIT_L(0); PG8_BAR; PG8_MMA(0, 0, At, B0); PG8_MMA(0, 1, At, B1); PG8_BAR; PG8_SCHED;
            PG8_LDA(At, 1, 1); PG8_STAGE(PG8_SB(1, 0), b3, voffB); PG8_STAGE(PG8_SB(1, 1), b3 + hstep, voffB); PG8_STAGE(PG8_SA(1, 0), a3, voffA);
            PG8_WAIT_V(8); PG8_WAIT_L(0); PG8_BAR; PG8_MMA(1, 0, At, B0); PG8_MMA(1, 1, At, B1); PG8_BAR; PG8_SCHED;
            } else {
            PG8_LDB(B0, 0, 0); PG8_SCHED; PG8_LDA(At, 0, 0); PG8_STAGE(PG8_SA(1, 1), a1 + hstep, voffA);
            PG8_WAIT_L(8); PG8_BAR; PG8_WAIT_L(0); PG8_MMA(0, 0, At, B0); PG8_BAR; PG8_SCHED;
            PG8_LDB(B1, 0, 1); PG8_STAGE(PG8_SB(0, 0), b2, voffB);
            PG8_BAR; PG8_WAIT_L(0); PG8_MMA(0, 1, At, B1); PG8_BAR;
            PG8_LDA(At, 0, 1); PG8_STAGE(PG8_SA(0, 0), a2, voffA);
            PG8_BAR; PG8_WAIT_L(0); PG8_MMA(1, 0, At, B0); PG8_BAR; PG8_SCHED;
            PG8_STAGE(PG8_SB(0, 1), b2 + hstep, voffB);
            PG8_WAIT_V(6); PG8_BAR; PG8_MMA(1, 1, At, B1); PG8_BAR;
            PG8_LDB(B0, 1, 0); PG8_SCHED; PG8_LDA(At, 1, 0); PG8_STAGE(PG8_SA(0, 1), a2 + hstep, voffA);
            PG8_WAIT_L(8); PG8_BAR; PG8_WAIT_L(0); PG8_MMA(0, 0, At, B0); PG8_BAR; PG8_SCHED;
            PG8_LDB(B1, 1, 1); PG8_STAGE(PG8_SB(1, 0), b3, voffB);
            PG8_BAR; PG8_WAIT_L(0); PG8_MMA(0, 1, At, B1); PG8_BAR;
            PG8_LDA(At, 1, 1); PG8_STAGE(PG8_SA(1, 0), a3, voffA);
            PG8_BAR; PG8_WAIT_L(0); PG8_MMA(1, 0, At, B0); PG8_BAR; PG8_SCHED;
            PG8_STAGE(PG8_SB(1, 1), b3 + hstep, voffB);
            PG8_WAIT_V(6); PG8_BAR; PG8_MMA(1, 1, At, B1); PG8_BAR;
            }
        }
        if constexpr (ALIGN_EPI) { if (wr == 0) PG8_BAR; }
        if constexpr (!Epi::AFTER_DRAIN) { E(acc, cur, wr, wc, fr, fq); S.done(cur); }
        if (!has_next) break;
#pragma unroll
        for (int a = 0; a < 2; ++a)
#pragma unroll
            for (int b = 0; b < 2; ++b)
#pragma unroll
                for (int m = 0; m < 4; ++m)
#pragma unroll
                    for (int n = 0; n < 2; ++n) acc[a][b][m][n] = (f32x4){0.f, 0.f, 0.f, 0.f};
        cur = nxt; cA = nA; cB = nB; ++ui;
        if constexpr (ALIGN_EPI) { if (wr == 1) PG8_BAR; }
    }
    PG8_WAIT_V(0);
    if constexpr (!ALIGN_EPI) { if (wr == 0) PG8_BAR; }
    PG8_BAR;
    if constexpr (Epi::AFTER_DRAIN) { E.fused(acc, cur, wr, wc, fr, fq, lds, wid, lane); S.done(cur); }
#undef PG8_SA
#undef PG8_SB
#undef PG8_STAGE
#undef PG8_LDA
#undef PG8_LDB
#undef PG8_MMA
#undef PG8_WAIT_V
#undef PG8_WAIT_L
#undef PG8_BAR
#undef PG8_SCHED
}
}
#include <hip/hip_bf16.h>
#include <cmath>
namespace attn_body {
using bf16=__hip_bfloat16;
using bf16x8=__attribute__((ext_vector_type(8)))short;
using s16x4=__attribute__((ext_vector_type(4)))short;
using f32x16=__attribute__((ext_vector_type(16)))float;
using u32x4=__attribute__((ext_vector_type(4)))unsigned;
constexpr int D=64;
constexpr int NW=8,QBLK=32,QB=QBLK*NW,KVBLK=64;
__device__ __forceinline__ int crow(int r,int hi){return (r&3)+8*(r>>2)+4*hi;}
#define SBAR() __builtin_amdgcn_sched_barrier(0)
constexpr int NSLOT=3, SLOTB=8192;
constexpr int LDS_K=0, LDS_V=NSLOT*SLOTB, LDS_WS=2*NSLOT*SLOTB, LDS_OST=LDS_WS+NW*64*4, LDS_BYTES=LDS_OST+NW*4096;
constexpr float C2=0.125f*1.4426950408889634f;
__device__ __forceinline__ void glds16(const void*gsrc,unsigned lds_dst){unsigned keep;
  asm volatile("s_mov_b32 %0, m0\n\ts_mov_b32 m0, %2\n\ts_nop 0\n\tglobal_load_lds_dwordx4 %1, off\n\ts_mov_b32 m0, %0":"=&s"(keep):"v"(gsrc),"s"(lds_dst):"memory");}
__device__ __forceinline__ float max3f(float a,float b,float c){float r;asm("v_max3_f32 %0, %1, %2, %3":"=v"(r):"v"(a),"v"(b),"v"(c));return r;}
__device__ __forceinline__ float max2f(float a,float b){float r;asm("v_max_f32_e32 %0, %1, %2":"=v"(r):"v"(a),"v"(b));return r;}
__device__ __forceinline__ float fadd_s(float a,float b){float r;asm("v_add_f32_e32 %0, %1, %2":"=v"(r):"v"(a),"v"(b));return r;}
__device__ __forceinline__ float fsub_s(float a,float b){float r;asm("v_sub_f32_e32 %0, %1, %2":"=v"(r):"v"(a),"v"(b));return r;}
typedef float f32x2_t __attribute__((ext_vector_type(2))); typedef __bf16 bf16x2_t __attribute__((ext_vector_type(2)));
__device__ __forceinline__ unsigned cvtpk_s(float lo,float hi){f32x2_t v={lo,hi};bf16x2_t b=__builtin_convertvector(v,bf16x2_t);return __builtin_bit_cast(unsigned,b);}
#define WAIT_BAR(N) asm volatile("s_waitcnt vmcnt(" #N ") lgkmcnt(0)\n\ts_barrier":::"memory")

__device__ __forceinline__ void qkt(f32x16&p0,f32x16&p1,const char*Kslot,const bf16x8*qr,const f32x16&negm,int r32,int hi){
  const char*kb=Kslot+hi*1024+r32*16;
  #pragma unroll
  for(int d0=0;d0<4;++d0){
    const bf16x8 b0=*reinterpret_cast<const bf16x8*>(kb+d0*2048);
    const bf16x8 b1=*reinterpret_cast<const bf16x8*>(kb+d0*2048+512);
    if(d0==0){p0=__builtin_amdgcn_mfma_f32_32x32x16_bf16(b0,qr[0],negm,0,0,0);p1=__builtin_amdgcn_mfma_f32_32x32x16_bf16(b1,qr[0],negm,0,0,0);}
    else{p0=__builtin_amdgcn_mfma_f32_32x32x16_bf16(b0,qr[d0],p0,0,0,0);p1=__builtin_amdgcn_mfma_f32_32x32x16_bf16(b1,qr[d0],p1,0,0,0);}}
}
typedef __attribute__((address_space(3))) const char* lds_cptr;
typedef short v4i16_t __attribute__((ext_vector_type(4)));
__device__ __forceinline__ void kload8(bf16x8*kf,lds_cptr kp){
  kf[0]=*(const __attribute__((address_space(3))) bf16x8*)(kp);      kf[1]=*(const __attribute__((address_space(3))) bf16x8*)(kp+512);
  kf[2]=*(const __attribute__((address_space(3))) bf16x8*)(kp+2048); kf[3]=*(const __attribute__((address_space(3))) bf16x8*)(kp+2560);
  kf[4]=*(const __attribute__((address_space(3))) bf16x8*)(kp+4096); kf[5]=*(const __attribute__((address_space(3))) bf16x8*)(kp+4608);
  kf[6]=*(const __attribute__((address_space(3))) bf16x8*)(kp+6144); kf[7]=*(const __attribute__((address_space(3))) bf16x8*)(kp+6656);
}
__device__ __forceinline__ void kload2(bf16x8*kf,lds_cptr kp,int j){ kf[2*j]=*(const __attribute__((address_space(3))) bf16x8*)(kp+j*2048); kf[2*j+1]=*(const __attribute__((address_space(3))) bf16x8*)(kp+j*2048+512); }
__device__ __forceinline__ s16x4 vtr(lds_cptr p){ return __builtin_bit_cast(s16x4,__builtin_amdgcn_ds_read_tr16_b64_v4i16((__attribute__((address_space(3))) v4i16_t*)p)); }
__device__ __forceinline__ float rowmax(const f32x16&p0,const f32x16&p1){
  float a=max3f(p0[0],p0[1],p1[0]),b=max3f(p0[2],p0[3],p1[1]);a=max3f(a,p1[2],p1[3]);
  #pragma unroll
  for(int r=4;r<16;r+=4){a=max3f(a,p0[r],p0[r+1]);b=max3f(b,p0[r+2],p0[r+3]);a=max3f(a,p1[r],p1[r+1]);b=max3f(b,p1[r+2],p1[r+3]);}
  const float m=max2f(a,b);
  auto rr=__builtin_amdgcn_permlane32_swap(__float_as_uint(m),__float_as_uint(m),false,false);
  return max2f(__uint_as_float(rr[0]),__uint_as_float(rr[1]));
}
__device__ __forceinline__ void pv(f32x16*o,int vb,bf16x8 pa0,bf16x8 pa1,bf16x8 pa2,bf16x8 pa3){
  #pragma unroll
  for(int d0=0;d0<2;++d0){s16x4 lo[4],hi[4];
    #pragma unroll
    for(int ks=0;ks<4;++ks){
      asm volatile("ds_read_b64_tr_b16 %0,%1 offset:%c2":"=&v"(lo[ks]):"v"(vb),"i"(d0*4096+ks*1024):"memory");
      asm volatile("ds_read_b64_tr_b16 %0,%1 offset:%c2":"=&v"(hi[ks]):"v"(vb),"i"(d0*4096+ks*1024+512):"memory");}
    asm volatile("s_waitcnt lgkmcnt(0)":::"memory");SBAR();
    #define PK(k) (bf16x8){lo[k][0],lo[k][1],lo[k][2],lo[k][3],hi[k][0],hi[k][1],hi[k][2],hi[k][3]}
    o[d0]=__builtin_amdgcn_mfma_f32_32x32x16_bf16(pa0,PK(0),o[d0],0,0,0);
    o[d0]=__builtin_amdgcn_mfma_f32_32x32x16_bf16(pa1,PK(1),o[d0],0,0,0);
    o[d0]=__builtin_amdgcn_mfma_f32_32x32x16_bf16(pa2,PK(2),o[d0],0,0,0);
    o[d0]=__builtin_amdgcn_mfma_f32_32x32x16_bf16(pa3,PK(3),o[d0],0,0,0);
    #undef PK
  }
}

#ifndef ATTN_STORE16
#define ATTN_STORE16(p,v) (*(u32x4*)(p)=(v))
#endif
constexpr int LDS_NATAB=86016;
__device__ __forceinline__ void namask(f32x16&p0,f32x16&p1,int kr,int rs,lds_cptr shm3,int toff,int cb){
  const float NEG=-INFINITY;
  if(kr>=rs&&kr<rs+8){
    const __attribute__((address_space(3))) float*tr=(const __attribute__((address_space(3))) float*)(shm3+LDS_NATAB)+(toff+kr*128);
    #pragma unroll
    for(int r=0;r<16;++r){const int c0=(r&3)+8*(r>>2);
      const float b0=tr[c0],b1=tr[c0+32];
      p0[r]=((unsigned)(c0+cb)<16u)?p0[r]+b0:NEG; p1[r]=((unsigned)(c0+32+cb)<16u)?p1[r]+b1:NEG;}
  }else{
    #pragma unroll
    for(int r=0;r<16;++r){p0[r]=NEG;p1[r]=NEG;}
  }
}
template<int MODE,int THRL,int QP,int KP> __device__ __forceinline__ void attn_unit(const bf16*Qu,const bf16*__restrict__ Kt,const bf16*__restrict__ Vt,bf16*Ou,const int NT,const int rq0,const int krow0,char*shm){
  int tid_=threadIdx.x; asm volatile("":"+v"(tid_)); const int tid=tid_,lane=tid&63,r32=lane&31,hi=lane>>5; const int wid=__builtin_amdgcn_readfirstlane(tid>>6);
  const bf16*Qw=Qu+(long)(wid*QBLK)*QP;
  const bf16*Kh=Kt,*Vh=Vt;
  const unsigned lds0=(unsigned)(uintptr_t)shm;
  float*wsf=(float*)(shm+LDS_WS)+wid*64;
  const bf16*ksrc=Kh+(long)lane*KP+wid*8;
  const bf16*vsrc=Vh+(long)(16*(wid&3)+(lane>>2))*KP+(wid>>2)*32+(lane&3)*8;
  const unsigned kdst=lds0+LDS_K+wid*1024, vdst=lds0+LDS_V+wid*1024;
  #define DMA_K(t,slot) glds16(ksrc+(long)(t)*KVBLK*KP,(unsigned)__builtin_amdgcn_readfirstlane(kdst+(slot)))
  #define DMA_V(t,slot) glds16(vsrc+(long)(t)*KVBLK*KP,(unsigned)__builtin_amdgcn_readfirstlane(vdst+(slot)))
  const int vb0=(int)(lds0+LDS_V)+((lane>>4)&1)*32+(lane&3)*8+(4*hi+((lane&15)>>2))*64;
  const char*Kbase=shm+LDS_K; bf16x8 kf[8];
  const lds_cptr shm3=(lds_cptr)shm; const lds_cptr kp0=shm3+LDS_K+hi*1024+r32*16; const lds_cptr vp0=shm3+LDS_V+((lane>>4)&1)*32+(lane&3)*8+(4*hi+((lane&15)>>2))*64;
  DMA_K(0,0);DMA_V(0,0);DMA_K(1,SLOTB);
  bf16x8 qr[4];
  #pragma unroll
  for(int d0=0;d0<4;++d0)qr[d0]=*reinterpret_cast<const bf16x8*>(&Qw[(long)r32*QP+d0*16+hi*8]);
  float mhat=0.f,l_reg=0.f;f32x16 o[2];o[0]=f32x16{};o[1]=f32x16{};f32x16 negm=f32x16{};asm volatile("":"+v"(negm));
  const int na_rq=rq0+(wid>>1), na_cq=32*(wid&1)+r32; const int na_rs=na_rq<4?0:(na_rq>28?24:na_rq-4); const int na_cs=na_cq<8?0:(na_cq>56?48:na_cq-8);
  const int na_toff=(7-na_rq)*128+63-na_cq+4*hi, na_cb=4*hi-na_cs;
  #define CMASK(P0,P1,t) do{ if constexpr(MODE==1) namask(P0,P1,krow0+(t),na_rs,shm3,na_toff,na_cb); }while(0)
  bool resc=false;
  #define START(P0,P1) do{ const float rm=rowmax(P0,P1); resc=false; \
    { const float dl=(MODE==1)?__builtin_fmaxf(rm,-16.f):rm; mhat=fadd_s(mhat,dl); \
      _Pragma("unroll") for(int r=0;r<16;++r){P0[r]=fsub_s(P0[r],dl);P1[r]=fsub_s(P1[r],dl);} \
      _Pragma("unroll") for(int r=0;r<16;++r)negm[r]=-mhat; asm volatile("":"+v"(negm)); } \
    _Pragma("unroll") for(int r=0;r<16;++r)P0[r]=__builtin_amdgcn_exp2f(P0[r]); }while(0)
  #define RESC() do{ if(resc){ asm volatile("s_waitcnt lgkmcnt(0)":::"memory"); \
      _Pragma("unroll") for(int d_=0;d_<2;++d_) _Pragma("unroll") for(int r=0;r<16;++r)o[d_][r]*=wsf[crow(r,hi)]; } }while(0)
  f32x16 pA0,pA1,pB0,pB1;
  int sl_prev=0,sl_cur=0,sl_next=SLOTB;
  #define ROT() do{sl_prev=sl_cur;sl_cur=sl_next;sl_next=(sl_next==(NSLOT-1)*SLOTB)?0:sl_next+SLOTB;}while(0)
  DMA_K(2,2*SLOTB);
  WAIT_BAR(3);
  qkt(pA0,pA1,Kbase,qr,negm,r32,hi);asm volatile("s_nop 15\n\ts_nop 7":"+v"(pA0),"+v"(pA1));CMASK(pA0,pA1,0);
  START(pA0,pA1);
  _Pragma("unroll") for(int r=0;r<16;++r)pA1[r]=__builtin_amdgcn_exp2f(pA1[r]);
  WAIT_BAR(0);
  DMA_K(3,0);DMA_V(1,SLOTB);
  ROT();
  kload8(kf,kp0+sl_cur);
  WAIT_BAR(2);
  s16x4 vlo[8],vhi[8]; u32x4 pw0,pw1,pw2,pw3;
  #define PKW(P,B) cvtpk_s(P[B],P[B+1])
  #define PAF(k) __builtin_bit_cast(bf16x8,pw##k)
  #define VFR(i) (bf16x8){vlo[i][0],vlo[i][1],vlo[i][2],vlo[i][3],vhi[i][0],vhi[i][1],vhi[i][2],vhi[i][3]}
  #define PIN(x) asm volatile("":"+v"(x))
  #define MX3(a,b,c) __builtin_fmaxf(__builtin_fmaxf((a),(b)),(c))
  #define GAPA(MF,A0,A1,A2,A3,W0,W1,PW) do{ MF; sacc+=A0; sacc+=A1; sacc+=A2; sacc+=A3; PIN(sacc); W0; W1; PIN(PW); SBAR(); }while(0)
  #define EX(v) __builtin_amdgcn_exp2f(v)
  #define GAPB(MF,X,B) do{ MF; X[B]=EX(X[B]); X[B+1]=EX(X[B+1]); X[B+2]=EX(X[B+2]); X[B+3]=EX(X[B+3]); PIN(X); SBAR(); }while(0)
  #define VRD(i) do{ vlo[i]=vtr(vp_+(((i)>>2)*4096+((i)&3)*1024)); vhi[i]=vtr(vp_+(((i)>>2)*4096+((i)&3)*1024+512)); }while(0)
  #define KRD(G,j) do{ if(G){ kload2(kf,kp0+sl_next,j); SBAR(); } }while(0)
  #define STEP(C0,C1,P0,P1,t,GK,GV,GL) do{ SBAR(); \
    const lds_cptr vp_=vp0+sl_prev; \
    VRD(0); SBAR(); float sacc=(P0[0]+P0[1]); \
    GAPA(C0=__builtin_amdgcn_mfma_f32_32x32x16_bf16(kf[0],qr[0],negm,0,0,0), P0[2],P0[3],P0[4],P0[5],     pw0[0]=PKW(P0,0), pw0[1]=PKW(P0,2), pw0); \
    VRD(4); SBAR(); GAPA(C1=__builtin_amdgcn_mfma_f32_32x32x16_bf16(kf[1],qr[0],negm,0,0,0), P0[6],P0[7],P0[8],P0[9],     pw0[2]=PKW(P0,4), pw0[3]=PKW(P0,6), pw0); \
    VRD(1); SBAR(); GAPA(C0=__builtin_amdgcn_mfma_f32_32x32x16_bf16(kf[2],qr[1],C0,0,0,0),   P0[10],P0[11],P0[12],P0[13], pw1[0]=PKW(P0,8), pw1[1]=PKW(P0,10), pw1); \
    VRD(5); SBAR(); GAPA(C1=__builtin_amdgcn_mfma_f32_32x32x16_bf16(kf[3],qr[1],C1,0,0,0),   P0[14],P0[15],P1[0],P1[1],   pw1[2]=PKW(P0,12),pw1[3]=PKW(P0,14), pw1); \
    VRD(2); SBAR(); GAPA(C0=__builtin_amdgcn_mfma_f32_32x32x16_bf16(kf[4],qr[2],C0,0,0,0),   P1[2],P1[3],P1[4],P1[5],     pw2[0]=PKW(P1,0), pw2[1]=PKW(P1,2), pw2); \
    VRD(6); SBAR(); GAPA(C1=__builtin_amdgcn_mfma_f32_32x32x16_bf16(kf[5],qr[2],C1,0,0,0),   P1[6],P1[7],P1[8],P1[9],     pw2[2]=PKW(P1,4), pw2[3]=PKW(P1,6), pw2); \
    VRD(3); SBAR(); GAPA(C0=__builtin_amdgcn_mfma_f32_32x32x16_bf16(kf[6],qr[3],C0,0,0,0),   P1[10],P1[11],P1[12],P1[13], pw3[0]=PKW(P1,8), pw3[1]=PKW(P1,10), pw3); \
    VRD(7); SBAR(); GAPA(C1=__builtin_amdgcn_mfma_f32_32x32x16_bf16(kf[7],qr[3],C1,0,0,0),   P1[14],P1[15],0.f,0.f,       pw3[2]=PKW(P1,12),pw3[3]=PKW(P1,14), pw3); \
    l_reg+=sacc; \
    if(GK){DMA_K((t)+3,sl_cur);} if(GV){DMA_V((t)+1,sl_next);} \
    CMASK(C0,C1,t); \
    { float a=MX3(C0[0],C0[1],C1[0]),b=MX3(C0[2],C0[3],C1[1]); a=MX3(a,C1[2],C1[3]); \
      _Pragma("unroll") for(int r=4;r<16;r+=4){a=MX3(a,C0[r],C0[r+1]);b=MX3(b,C0[r+2],C0[r+3]);a=MX3(a,C1[r],C1[r+1]);b=MX3(b,C1[r+2],C1[r+3]);} \
      float rm=__builtin_fmaxf(a,b); { auto rr=__builtin_amdgcn_permlane32_swap(__float_as_uint(rm),__float_as_uint(rm),false,false); rm=__builtin_fmaxf(__uint_as_float(rr[0]),__uint_as_float(rr[1])); } \
      resc=false; \
      if(__builtin_expect(__any(rm>(float)THRL),0)){ const float dl=__builtin_fmaxf(rm,0.f); mhat+=dl; \
        _Pragma("unroll") for(int r=0;r<16;++r){C0[r]-=dl;C1[r]-=dl;} \
        _Pragma("unroll") for(int r=0;r<16;++r)negm[r]=-mhat; asm volatile("":"+v"(negm)); \
        const float f=__builtin_amdgcn_exp2f(-dl); l_reg*=f; if(hi==0)wsf[r32]=f; resc=true; } } \
    SBAR(); \
    GAPB(o[0]=__builtin_amdgcn_mfma_f32_32x32x16_bf16(PAF(0),VFR(0),o[0],0,0,0), C0,0); \
    GAPB(o[1]=__builtin_amdgcn_mfma_f32_32x32x16_bf16(PAF(0),VFR(4),o[1],0,0,0), C0,4); \
    KRD(GL,0); GAPB(o[0]=__builtin_amdgcn_mfma_f32_32x32x16_bf16(PAF(1),VFR(1),o[0],0,0,0), C0,8); \
    KRD(GL,1); GAPB(o[1]=__builtin_amdgcn_mfma_f32_32x32x16_bf16(PAF(1),VFR(5),o[1],0,0,0), C0,12); \
    KRD(GL,2); GAPB(o[0]=__builtin_amdgcn_mfma_f32_32x32x16_bf16(PAF(2),VFR(2),o[0],0,0,0), C1,0); \
    KRD(GL,3); GAPB(o[1]=__builtin_amdgcn_mfma_f32_32x32x16_bf16(PAF(2),VFR(6),o[1],0,0,0), C1,4); \
    GAPB(o[0]=__builtin_amdgcn_mfma_f32_32x32x16_bf16(PAF(3),VFR(3),o[0],0,0,0), C1,8); \
    GAPB(o[1]=__builtin_amdgcn_mfma_f32_32x32x16_bf16(PAF(3),VFR(7),o[1],0,0,0), C1,12); \
    }while(0)
  int t=1;
  for(;t+5<NT;t+=2){
    STEP(pB0,pB1,pA0,pA1,t,true,true,true);     WAIT_BAR(2); RESC(); ROT();
    STEP(pA0,pA1,pB0,pB1,t+1,true,true,true);   WAIT_BAR(2); RESC(); ROT();
  }
  #define ENDW(tt) do{ if((tt)+3<NT){WAIT_BAR(2);} else if((tt)+2<NT){WAIT_BAR(1);} else {WAIT_BAR(0);} }while(0)
  for(;t+1<NT;t+=2){
    STEP(pB0,pB1,pA0,pA1,t,(t+3<NT),(t+1<NT),(t+1<NT));       ENDW(t);   RESC(); ROT();
    STEP(pA0,pA1,pB0,pB1,t+1,(t+4<NT),(t+2<NT),(t+2<NT));     ENDW(t+1); RESC(); ROT();
  }
  STEP(pB0,pB1,pA0,pA1,NT-1,false,false,false); RESC();
  { float sacc=pB0[0]+pB0[1]; _Pragma("unroll") for(int r=2;r<16;++r)sacc+=pB0[r]; _Pragma("unroll") for(int r=0;r<16;++r)sacc+=pB1[r]; l_reg+=sacc;
    pw0=(u32x4){PKW(pB0,0),PKW(pB0,2),PKW(pB0,4),PKW(pB0,6)};pw1=(u32x4){PKW(pB0,8),PKW(pB0,10),PKW(pB0,12),PKW(pB0,14)};pw2=(u32x4){PKW(pB1,0),PKW(pB1,2),PKW(pB1,4),PKW(pB1,6)};pw3=(u32x4){PKW(pB1,8),PKW(pB1,10),PKW(pB1,12),PKW(pB1,14)};
    SBAR(); pv(o,vb0+sl_cur,PAF(0),PAF(1),PAF(2),PAF(3)); }
  #undef PKW
  #undef PAF
  #undef VFR
  #undef PIN
  #undef MX3
  #undef GAPA
  #undef GAPB
  #undef EX
  #undef VRD
  #undef KRD
  #undef STEP
  #undef ENDW
  {auto rr=__builtin_amdgcn_permlane32_swap(__float_as_uint(l_reg),__float_as_uint(l_reg),false,false);l_reg=__uint_as_float(rr[0])+__uint_as_float(rr[1]);}
  if(hi==0)wsf[32+r32]=l_reg;asm volatile("s_waitcnt lgkmcnt(0)":::"memory");
  float rli[16];
  #pragma unroll
  for(int r=0;r<16;++r)rli[r]=__builtin_amdgcn_rcpf(wsf[32+crow(r,hi)]);
  bf16*Ow=Ou+(long)(wid*QBLK)*QP;
  { bf16*stg=(bf16*)(shm+LDS_OST)+wid*2048;
    #pragma unroll
    for(int r=0;r<16;++r){const int orow=crow(r,hi);
      #pragma unroll
      for(int d0=0;d0<2;++d0)stg[orow*64+d0*32+r32]=__float2bfloat16(o[d0][r]*rli[r]);}
    asm volatile("s_waitcnt lgkmcnt(0)":::"memory");
    #pragma unroll
    for(int i=0;i<4;++i){const int row=i*8+(lane>>3),ch=lane&7; const u32x4 v=*(const u32x4*)(stg+row*64+ch*8); ATTN_STORE16(Ow+(long)row*QP+ch*8,v);} }
  asm volatile("s_waitcnt lgkmcnt(0)\n\ts_barrier":::"memory");
  #undef DMA_K
  #undef DMA_V
  #undef CMASK
  #undef START
  #undef RESC
  #undef ROT
}
}

constexpr int NWAVES = 8;
constexpr int RING_OFF = 0, RING_BYTES = 131072;
constexpr int LDSCTL_OFF = RING_BYTES, MISC_OFF = LDSCTL_OFF + 320;
constexpr int LDS_BYTES = 147456;
static_assert(MISC_OFF + 128 <= LDS_BYTES, "LDS map");

#define GAS __attribute__((address_space(1)))
#define LAS __attribute__((address_space(3)))
typedef unsigned short bf16;
typedef unsigned v4u __attribute__((ext_vector_type(4)));
typedef float f32x4 __attribute__((ext_vector_type(4)));
typedef short bf16x8 __attribute__((ext_vector_type(8)));
typedef GAS unsigned gu32;
typedef GAS unsigned long long gu64;
#define RLX_AGENT __ATOMIC_RELAXED, __HIP_MEMORY_SCOPE_AGENT
#define LDS_WAIT() asm volatile("s_waitcnt lgkmcnt(0)" ::: "memory")
#define VM_WAIT() asm volatile("s_waitcnt vmcnt(0)" ::: "memory")
__device__ __forceinline__ unsigned long long rt() { return __builtin_amdgcn_s_memrealtime(); }
__device__ __forceinline__ unsigned f2bf(float f) { unsigned u = __builtin_bit_cast(unsigned, f); return (u + 0x7fffu + ((u >> 16) & 1u)) >> 16; }
__device__ __forceinline__ unsigned pk2(float lo, float hi) { return f2bf(lo) | (f2bf(hi) << 16); }

#define XB_TMO      128
#define XB_XCNT(j)  (256  + 64 * (j))
#define XB_XSUB(j)  (1280 + 64 * (j))
#define XB_XGEN(j)  (2304 + 64 * (j))
#define XB_TOP      3328
#define XB_TOPGEN   3392
#define XCD_BAR_WORDS 3456
#define XB_SPIN_CAP (1u << 18)

__device__ __forceinline__ unsigned xb_ld(unsigned* p)              { return __hip_atomic_load(p, __ATOMIC_RELAXED, __HIP_MEMORY_SCOPE_AGENT); }
__device__ __forceinline__ unsigned xb_add(unsigned* p, unsigned v) { return __hip_atomic_fetch_add(p, v, __ATOMIC_RELAXED, __HIP_MEMORY_SCOPE_AGENT); }
__device__ __forceinline__ unsigned xb_xcc_id() { return (unsigned)__builtin_amdgcn_s_getreg((3 << 11) | 20) & 0xFu; }
#define XB_SPIN(cond, bar) do { unsigned _sp = 0; while (cond) { __builtin_amdgcn_s_sleep(1); \
    if ((++_sp & 255u) == 0u) { if (xb_ld(&(bar)[XB_TMO])) break; if (_sp > XB_SPIN_CAP) { atomicAdd(&(bar)[XB_TMO], 1u); break; } } } } while (0)

struct XcdBarrier {
    unsigned* bar; unsigned x;
    volatile LAS unsigned* st;
};

__device__ __forceinline__ XcdBarrier xcd_barrier_post(unsigned* bar, volatile LAS unsigned* st) {
    XcdBarrier b; b.bar = bar; b.x = xb_xcc_id(); b.st = st;
    if (threadIdx.x == 0) (void)xb_add(&bar[XB_XCNT(b.x)], 1u);
    return b;
}
__device__ __forceinline__ void xcd_barrier_complete(unsigned* bar, unsigned x, unsigned& nloc, unsigned& nx) {
    const unsigned G = gridDim.x * gridDim.y * gridDim.z;
    unsigned sum, cnt, mine, sp = 0u;
    for (;;) {
        sum = 0u; cnt = 0u; mine = 0u;
#pragma unroll
        for (unsigned j = 0; j < 16; ++j) { const unsigned c = xb_ld(&bar[XB_XCNT(j)]); sum += c; cnt += (c > 0u) ? 1u : 0u; mine = (j == x) ? c : mine; }
        if (sum == G) break;
        __builtin_amdgcn_s_sleep(1);
        if ((++sp & 255u) == 0u) { if (xb_ld(&bar[XB_TMO])) break; if (sp > XB_SPIN_CAP) { atomicAdd(&bar[XB_TMO], 1u); break; } }
    }
    nloc = mine > 0u ? mine : 1u; nx = cnt > 0u ? cnt : 1u;
}

__device__ __forceinline__ void xcd_barrier(const XcdBarrier& b) {
    asm volatile("s_waitcnt vmcnt(0)" ::: "memory");
    __syncthreads();
    if (threadIdx.x == 0) {
        unsigned* bar = b.bar;
        __builtin_amdgcn_s_waitcnt(0);
        unsigned nloc = b.st[0], nx = b.st[1];
        if (nloc == 0u) { xcd_barrier_complete(bar, b.x, nloc, nx); b.st[0] = nloc; b.st[1] = nx; }
        const unsigned old = xb_add(&bar[XB_XSUB(b.x)], 1u);
        const unsigned gen = old / nloc;
        if (old + 1u == (gen + 1u) * nloc) {
            __builtin_amdgcn_fence(__ATOMIC_RELEASE, "agent");
            asm volatile("s_waitcnt vmcnt(0)" ::: "memory");
            const unsigned og = xb_add(&bar[XB_TOP], 1u);
            const unsigned tg = og / nx;
            if (og + 1u == (tg + 1u) * nx) xb_add(&bar[XB_TOPGEN], 1u);
            else XB_SPIN(xb_ld(&bar[XB_TOPGEN]) == tg, bar);
            __builtin_amdgcn_fence(__ATOMIC_ACQUIRE, "agent");
            xb_add(&bar[XB_XGEN(b.x)], 1u);
            asm volatile("s_waitcnt vmcnt(0)" ::: "memory");
        } else {
            XB_SPIN(xb_ld(&bar[XB_XGEN(b.x)]) == gen, bar);
            __builtin_amdgcn_fence(__ATOMIC_ACQUIRE, "agent");
            asm volatile("s_waitcnt vmcnt(0)" ::: "memory");
        }
    }
    __syncthreads();
}

struct Frame {
    LAS unsigned char* lds;
    int vcu, G;
};
#define OPAQUE_TID(tid) int tid = threadIdx.x; asm volatile("" : "+v"(tid))
__device__ __forceinline__ float wave_sum(float v) {
#pragma unroll
    for (int o = 1; o < 64; o <<= 1) v += __shfl_xor(v, o);
    return v;
}
__device__ __forceinline__ int phys_row(int mode, int L) {
    if (mode == 0) return L;
    const int tile = L >> 8, lt = L & 255;
    if (mode == 2 && tile >= 6 && tile <= 8) return (tile << 8) + 128 * ((lt >> 5) & 1) + 32 * (lt >> 6) + (lt & 31);
    const int l = L & 31; return (L & ~31) + 16 * ((l >> 2) & 1) + 4 * (l >> 3) + (l & 3);
}
__device__ __forceinline__ void p0_transpose_item(const float* W, int K, int N, bf16* WT, int mode, LAS float* scr, int item, int lane) {
    const int nblk = N / 32, kb = item / nblk, nb = item % nblk, k0 = 64 * kb, n0 = 32 * nb;
#pragma unroll 8
    for (int i = 0; i < 32; ++i) { const int kk = 2 * i + (lane >> 5); scr[kk * 33 + (lane & 31)] = W[(size_t)(k0 + kk) * N + n0 + (lane & 31)]; }
    LDS_WAIT(); asm volatile("" ::: "memory");
    const int c = lane & 7;
#pragma unroll
    for (int j = 0; j < 4; ++j) { const int n = (lane >> 3) + 8 * j; const LAS float* s = scr + (8 * c) * 33 + n;
        v4u o; o.x = pk2(s[0 * 33], s[1 * 33]); o.y = pk2(s[2 * 33], s[3 * 33]); o.z = pk2(s[4 * 33], s[5 * 33]); o.w = pk2(s[6 * 33], s[7 * 33]);
        *(GAS v4u*)(WT + (size_t)phys_row(mode, n0 + n) * K + k0 + 8 * c) = o; }
    LDS_WAIT(); asm volatile("" ::: "memory");
}
__device__ __forceinline__ void rms_row_to_bf16(int lane, const float* xrow, const float* g, bf16* orow) {
    const GAS f32x4* xr = (const GAS f32x4*)xrow + lane; const GAS f32x4* gr = (const GAS f32x4*)g + lane;
    f32x4 v[4]; float s = 0.f;
#pragma unroll
    for (int j = 0; j < 4; ++j) { v[j] = xr[64 * j]; s += (v[j].x * v[j].x + v[j].y * v[j].y) + (v[j].z * v[j].z + v[j].w * v[j].w); }
    const float rstd = 1.f / sqrtf(wave_sum(s) * (1.f / D) + EPS);
    GAS unsigned long long* o8 = (GAS unsigned long long*)orow + lane;
#pragma unroll
    for (int j = 0; j < 4; ++j) { const f32x4 gg = gr[64 * j]; o8[64 * j] = (unsigned long long)pk2(v[j].x * rstd * gg.x, v[j].y * rstd * gg.y) | ((unsigned long long)pk2(v[j].z * rstd * gg.z, v[j].w * rstd * gg.w) << 32); }
}
__device__ __forceinline__ void cvt_stream(const float* src, bf16* dst, size_t n8, size_t gtid, size_t gthreads) {
    for (size_t i = gtid; i < n8; i += gthreads) { const f32x4 a = ((const GAS f32x4*)src)[2 * i], b = ((const GAS f32x4*)src)[2 * i + 1];
        v4u o; o.x = pk2(a.x, a.y); o.y = pk2(a.z, a.w); o.z = pk2(b.x, b.y); o.w = pk2(b.z, b.w); ((GAS v4u*)dst)[i] = o; }
}
#define CAND_LIST CAND(0,0,0) CAND(1,0,1) CAND(2,0,2) CAND(3,0,3) CAND(4,0,4) CAND(5,0,5) CAND(6,0,6) CAND(7,0,7) CAND(8,0,8) CAND(9,0,9) CAND(10,0,10) CAND(11,0,11) CAND(12,0,12) CAND(13,0,13) CAND(14,0,14) CAND(15,0,15) CAND(16,1,0) CAND(17,1,1) CAND(18,1,2) CAND(19,1,3) CAND(20,1,4) CAND(21,1,5) CAND(22,1,6) CAND(23,1,7) CAND(24,2,0) CAND(25,2,1) CAND(26,2,2) CAND(27,2,3) CAND(28,2,4) CAND(29,3,0) CAND(30,3,1) CAND(31,3,2) CAND(32,3,3) CAND(33,4,0) CAND(34,4,1) CAND(35,4,2) CAND(36,5,0) CAND(37,5,1) CAND(38,6,0) CAND(39,6,1) CAND(40,7,0) CAND(41,7,1) CAND(42,8,0) CAND(43,9,0) CAND(44,10,0) CAND(45,11,0) CAND(46,12,0) CAND(47,13,0) CAND(48,14,0) CAND(49,15,0)
__device__ __forceinline__ int ford(unsigned bits) { const int k = (int)bits; return k ^ ((k >> 31) & 0x7fffffff); }
__device__ __forceinline__ int imx(int a, int b) { return a > b ? a : b; }
__device__ __forceinline__ int imn(int a, int b) { return a < b ? a : b; }
#define CE_D(a, b) do { const int _x = imx(a, b), _n = imn(a, b); a = _x; b = _n; } while (0)
#define CE_A(a, b) do { const int _x = imx(a, b), _n = imn(a, b); a = _n; b = _x; } while (0)
__device__ __forceinline__ void sort16_desc(int (&v)[16]) {
#pragma unroll
    for (int k = 2; k <= 16; k <<= 1)
#pragma unroll
        for (int j = k >> 1; j > 0; j >>= 1)
#pragma unroll
            for (int i = 0; i < 16; ++i) { const int l = i ^ j; if (l > i) { if ((i & k) == 0) CE_D(v[i], v[l]); else CE_A(v[i], v[l]); } }
}
__device__ __forceinline__ void bmerge16(int (&v)[16]) {
#pragma unroll
    for (int j = 8; j > 0; j >>= 1)
#pragma unroll
        for (int i = 0; i < 16; ++i) { const int l = i ^ j; if (l > i) CE_D(v[i], v[l]); }
}
__device__ __forceinline__ void merge_top16(int (&a)[16], const int (&b)[16]) {
#pragma unroll
    for (int i = 0; i < 16; ++i) a[i] = imx(a[i], b[15 - i]);
    bmerge16(a);
}
__device__ __forceinline__ void top16_of_64(const int (&v)[64], int (&out)[16]) {
    int g1[16], g2[16], g3[16];
#pragma unroll
    for (int i = 0; i < 16; ++i) { out[i] = v[i]; g1[i] = v[16 + i]; g2[i] = v[32 + i]; g3[i] = v[48 + i]; }
    sort16_desc(out); sort16_desc(g1); sort16_desc(g2); sort16_desc(g3);
    merge_top16(out, g1); merge_top16(g2, g3); merge_top16(out, g2);
}
typedef float f32x16v __attribute__((ext_vector_type(16)));
constexpr int RT_SCR = 65536;
__device__ __forceinline__ int mkc(int x, int y, unsigned code) {
    const float fs = __builtin_bit_cast(float, (unsigned)ford((unsigned)x)) + __builtin_bit_cast(float, (unsigned)ford((unsigned)y));
    return ford((__builtin_bit_cast(unsigned, fs) & 0xFFFFFF00u) | code); }
__device__ __forceinline__ void route_phase(const Frame& F, unsigned char* ws) {
    const GAS bf16* SUBK = (const GAS bf16*)(ws + WS_SUBK); const GAS bf16* Q2 = (const GAS bf16*)(ws + WS_Q2);
    GAS int* IDX = (GAS int*)(ws + WS_IDX); GAS float* GATE = (GAS float*)(ws + WS_GATE);
    OPAQUE_TID(tid);
    const int lane = tid & 63, r32 = lane & 31, hi = lane >> 5, wid = __builtin_amdgcn_readfirstlane(tid >> 6);
    int cur_h = -1;
    for (int uid = F.vcu; uid < 8 * (T / 256); uid += F.G) {
        const int hh = uid & 7, tok = (uid >> 3) * 256 + wid * 32 + r32;
        if (hh != cur_h) {
            __syncthreads();
#pragma unroll
            for (int it = 0; it < 8; ++it) { const int id = tid + it * 512, p = id >> 11, n = (id >> 4) & 127, ch = id & 15;
                const v4u w = *(const GAS v4u*)(SUBK + ((size_t)((hh * 2 + p) * 128 + n) * 128 + ch * 8));
                *(LAS v4u*)(F.lds + p * 32768 + ch * 2048 + n * 16) = w; }
            __syncthreads(); cur_h = hh;
        }
        int lst[2][16];
#pragma unroll
        for (int p = 0; p < 2; ++p) {
            f32x16v acc[4];
#pragma unroll
            for (int nt = 0; nt < 4; ++nt) { acc[nt] = (f32x16v){}; asm volatile("" : "+v"(acc[nt])); }
            const GAS bf16* qp = Q2 + (size_t)tok * 2048 + hh * 256 + p * 128 + hi * 8;
            bf16x8 bq[8];
#pragma unroll
            for (int ks = 0; ks < 8; ++ks) bq[ks] = *(const GAS bf16x8*)(qp + ks * 16);
#pragma unroll
            for (int ks = 0; ks < 8; ++ks)
#pragma unroll
                for (int nt = 0; nt < 4; ++nt) { const bf16x8 af = *(const LAS bf16x8*)(F.lds + p * 32768 + (2 * ks + hi) * 2048 + (nt * 32 + r32) * 16);
                    acc[nt] = __builtin_amdgcn_mfma_f32_32x32x16_bf16(af, bq[ks], acc[nt], 0, 0, 0); }
            int v[64];
            const unsigned h4 = (unsigned)hi << 2;
#pragma unroll
            for (int nt = 0; nt < 4; ++nt)
#pragma unroll
                for (int r = 0; r < 16; ++r) { const float sc_ = acc[nt][r];
                    v[nt * 16 + r] = ford((__builtin_bit_cast(unsigned, sc_) & 0xFFFFFF80u) | (unsigned)(32 * nt + (r & 3) + 8 * (r >> 2)) | h4); }
            int mine[16], oth[16];
            top16_of_64(v, mine);
#pragma unroll
            for (int i = 0; i < 16; ++i) oth[i] = __shfl_xor(mine[i], 32);
            merge_top16(mine, oth);
#pragma unroll
            for (int i = 0; i < 16; ++i) lst[p][i] = mine[i];
        }
        LAS unsigned* scr = (LAS unsigned*)(F.lds + RT_SCR + wid * 2048 + lane * 32);
#pragma unroll
        for (int p = 0; p < 2; ++p)
#pragma unroll
            for (int q = 0; q < 4; ++q) { unsigned w = 0;
#pragma unroll
                for (int b = 0; b < 4; ++b) w |= ((unsigned)ford((unsigned)lst[p][4 * q + b]) & 127u) << (8 * b);
                scr[p * 4 + q] = w; }
        int cv[64];
#define CAND(c, i, j) cv[c] = mkc(lst[0][i], lst[1][j], (unsigned)((i) * 16 + (j)));
        CAND_LIST
#undef CAND
#pragma unroll
        for (int c = 50; c < 64; ++c) cv[c] = (int)0x80000000;
        int best[16];
        top16_of_64(cv, best);
        asm volatile("s_waitcnt lgkmcnt(0)" ::: "memory");
        const LAS unsigned char* sb = (const LAS unsigned char*)scr;
        int ex[16]; float gt[16]; float gs = 0.f;
        const float b0 = __builtin_bit_cast(float, (unsigned)ford((unsigned)best[0]));
#pragma unroll
        for (int k = 0; k < 16; ++k) { const unsigned kb = (unsigned)ford((unsigned)best[k]), code = kb & 255u;
            ex[k] = (int)sb[code >> 4] * 128 + (int)sb[16 + (code & 15)];
            gt[k] = __builtin_amdgcn_exp2f((__builtin_bit_cast(float, kb) - b0) * 1.4426950408889634f); gs += gt[k]; }
        const float rg = 1.0f / gs;
        if (hi == 0) {
            GAS v4u* ip = (GAS v4u*)(IDX + (size_t)tok * 128 + hh * 16);
#pragma unroll
            for (int q = 0; q < 4; ++q) ip[q] = (v4u){(unsigned)ex[4 * q], (unsigned)ex[4 * q + 1], (unsigned)ex[4 * q + 2], (unsigned)ex[4 * q + 3]};
        } else {
            GAS f32x4* gp = (GAS f32x4*)(GATE + (size_t)tok * 128 + hh * 16);
#pragma unroll
            for (int q = 0; q < 4; ++q) gp[q] = (f32x4){gt[4 * q] * rg, gt[4 * q + 1] * rg, gt[4 * q + 2] * rg, gt[4 * q + 3] * rg};
        }
    }
    __syncthreads();
}
using pg8::bf_lo; using pg8::bf_hi;
typedef __bf16 bf16x2v __attribute__((ext_vector_type(2)));
__device__ __forceinline__ float dot2(unsigned a, unsigned b, float c) { return __builtin_amdgcn_fdot2_f32_bf16(__builtin_bit_cast(bf16x2v, a), __builtin_bit_cast(bf16x2v, b), c, false); }
__device__ __forceinline__ void expert_phase(const Frame& F, unsigned char* ws, const float* gf_, float* out_) {
    const GAS bf16* U = (const GAS bf16*)(ws + WS_U); const GAS bf16* V = (const GAS bf16*)(ws + WS_V); const GAS bf16* XN = (const GAS bf16*)(ws + WS_XN);
    const GAS int* IDX = (const GAS int*)(ws + WS_IDX); const GAS float* GATE = (const GAS float*)(ws + WS_GATE);
    const GAS float* gf = (const GAS float*)gf_; GAS float* out = (GAS float*)out_;
    OPAQUE_TID(tid);
    const int lane = tid & 63; const int gw = F.vcu * NWAVES + __builtin_amdgcn_readfirstlane(tid >> 6), NGW = F.G * NWAVES;
    for (int t = gw; t < T; t += NGW) {
        const int i0 = IDX[(size_t)t * 128 + lane], i1 = IDX[(size_t)t * 128 + 64 + lane];
        const float g0 = GATE[(size_t)t * 128 + lane], g1 = GATE[(size_t)t * 128 + 64 + lane];
        const v4u x0 = *(const GAS v4u*)(XN + (size_t)t * D + 8 * lane), x1 = *(const GAS v4u*)(XN + (size_t)t * D + 512 + 8 * lane);
        float a0 = 0.f, a1 = 0.f;
#pragma unroll 8
        for (int e = 0; e < 64; ++e) { const int row = __builtin_amdgcn_readlane(i0, e); const GAS bf16* up = U + (size_t)row * D + 8 * lane;
            const v4u u0 = *(const GAS v4u*)up, u1 = *(const GAS v4u*)(up + 512);
            float d0 = dot2(x0.x, u0.x, 0.f), d1 = dot2(x1.x, u1.x, 0.f); d0 = dot2(x0.y, u0.y, d0); d1 = dot2(x1.y, u1.y, d1); d0 = dot2(x0.z, u0.z, d0); d1 = dot2(x1.z, u1.z, d1); d0 = dot2(x0.w, u0.w, d0); d1 = dot2(x1.w, u1.w, d1);
            const float d = wave_sum(d0 + d1); a0 = (lane == e) ? d : a0; }
#pragma unroll 8
        for (int e = 0; e < 64; ++e) { const int row = __builtin_amdgcn_readlane(i1, e); const GAS bf16* up = U + (size_t)row * D + 8 * lane;
            const v4u u0 = *(const GAS v4u*)up, u1 = *(const GAS v4u*)(up + 512);
            float d0 = dot2(x0.x, u0.x, 0.f), d1 = dot2(x1.x, u1.x, 0.f); d0 = dot2(x0.y, u0.y, d0); d1 = dot2(x1.y, u1.y, d1); d0 = dot2(x0.z, u0.z, d0); d1 = dot2(x1.z, u1.z, d1); d0 = dot2(x0.w, u0.w, d0); d1 = dot2(x1.w, u1.w, d1);
            const float d = wave_sum(d0 + d1); a1 = (lane == e) ? d : a1; }
        const float h0 = 0.5f * a0 * (1.f + erff(a0 * 0.70710678118654752f)) * g0, h1 = 0.5f * a1 * (1.f + erff(a1 * 0.70710678118654752f)) * g1;
        float o[16];
#pragma unroll
        for (int k = 0; k < 16; ++k) o[k] = 0.f;
#pragma unroll 8
        for (int e = 0; e < 64; ++e) { const int row = __builtin_amdgcn_readlane(i0, e); const float hv = __builtin_bit_cast(float, __builtin_amdgcn_readlane(__builtin_bit_cast(int, h0), e));
            const GAS bf16* vp = V + (size_t)row * D + 8 * lane; const v4u v0 = *(const GAS v4u*)vp, v1 = *(const GAS v4u*)(vp + 512);
            o[0] += hv * bf_lo(v0.x); o[1] += hv * bf_hi(v0.x); o[2] += hv * bf_lo(v0.y); o[3] += hv * bf_hi(v0.y); o[4] += hv * bf_lo(v0.z); o[5] += hv * bf_hi(v0.z); o[6] += hv * bf_lo(v0.w); o[7] += hv * bf_hi(v0.w);
            o[8] += hv * bf_lo(v1.x); o[9] += hv * bf_hi(v1.x); o[10] += hv * bf_lo(v1.y); o[11] += hv * bf_hi(v1.y); o[12] += hv * bf_lo(v1.z); o[13] += hv * bf_hi(v1.z); o[14] += hv * bf_lo(v1.w); o[15] += hv * bf_hi(v1.w); }
#pragma unroll 8
        for (int e = 0; e < 64; ++e) { const int row = __builtin_amdgcn_readlane(i1, e); const float hv = __builtin_bit_cast(float, __builtin_amdgcn_readlane(__builtin_bit_cast(int, h1), e));
            const GAS bf16* vp = V + (size_t)row * D + 8 * lane; const v4u v0 = *(const GAS v4u*)vp, v1 = *(const GAS v4u*)(vp + 512);
            o[0] += hv * bf_lo(v0.x); o[1] += hv * bf_hi(v0.x); o[2] += hv * bf_lo(v0.y); o[3] += hv * bf_hi(v0.y); o[4] += hv * bf_lo(v0.z); o[5] += hv * bf_hi(v0.z); o[6] += hv * bf_lo(v0.w); o[7] += hv * bf_hi(v0.w);
            o[8] += hv * bf_lo(v1.x); o[9] += hv * bf_hi(v1.x); o[10] += hv * bf_lo(v1.y); o[11] += hv * bf_hi(v1.y); o[12] += hv * bf_lo(v1.z); o[13] += hv * bf_hi(v1.z); o[14] += hv * bf_lo(v1.w); o[15] += hv * bf_hi(v1.w); }
        GAS f32x4* xr = (GAS f32x4*)(out + (size_t)t * D + 8 * lane);
        f32x4 y[4]; y[0] = xr[0]; y[1] = xr[1]; y[2] = xr[128]; y[3] = xr[129];
        float ss = 0.f;
#pragma unroll
        for (int q = 0; q < 4; ++q) { y[q] = y[q] + (f32x4){o[4 * q], o[4 * q + 1], o[4 * q + 2], o[4 * q + 3]}; ss += (y[q].x * y[q].x + y[q].y * y[q].y) + (y[q].z * y[q].z + y[q].w * y[q].w); }
        const float r = 1.f / sqrtf(wave_sum(ss) * (1.f / D) + EPS);
        const GAS f32x4* gr = (const GAS f32x4*)(gf + 8 * lane);
        xr[0] = y[0] * r * gr[0]; xr[1] = y[1] * r * gr[1]; xr[128] = y[2] * r * gr[128]; xr[129] = y[3] * r * gr[129];
    }
}
struct Args { const float* in[15]; float* out; unsigned char* ws; };
#define KARGS(ap) const __attribute__((address_space(4))) Args* ap; { auto kp_ = __builtin_amdgcn_kernarg_segment_ptr(); asm volatile("" : "+s"(kp_)); ap = (const __attribute__((address_space(4))) Args*)kp_; }
#define PGG(T_, p) ((PG8_GAS T_*)(p))
__global__ void __launch_bounds__(NWAVES * 64, 2) mk_fwd(Args args) {
    extern __shared__ __attribute__((aligned(16))) unsigned char lds[];
    Frame F;
    F.lds = (LAS unsigned char*)lds;
    F.G = gridDim.x; { const int bx = blockIdx.x; F.vcu = (F.G % 8 == 0) ? (bx % 8) * (F.G / 8) + bx / 8 : bx; }
    XcdBarrier bar;
    {
        OPAQUE_TID(tid);
        for (int u = tid; u < (LDS_BYTES - LDSCTL_OFF) / 4; u += NWAVES * 64) ((LAS unsigned*)(F.lds + LDSCTL_OFF))[u] = 0u;
        __syncthreads();
        bar = xcd_barrier_post((unsigned*)(args.ws + WS_CTL) + CW_BAR, (volatile LAS unsigned*)(F.lds + MISC_OFF) + 8);
    }

    {
        KARGS(ap); unsigned char* ws = ap->ws; OPAQUE_TID(tid);
        const int lane = tid & 63, wave = __builtin_amdgcn_readfirstlane(tid >> 6), gw = F.vcu * NWAVES + wave, NGW = F.G * NWAVES;
        LAS float* scr = (LAS float*)(F.lds + RING_OFF + wave * 16384);
        constexpr int I_IN = (D / 64) * (INW / 32), I_A = (512 / 64) * (D / 32), I_O = (D / 64) * (D / 32), I_Q = (D / 64) * (2048 / 32);
        constexpr int NITEMS = I_IN + 2 * I_A + I_O + I_Q;
        for (int it = gw; it < NITEMS; it += NGW) {
            int r = it;
            if (r < I_IN) { p0_transpose_item(ap->in[2], D, INW, (bf16*)(ws + WS_WIN), 2, scr, r, lane); continue; } r -= I_IN;
            if (r < I_A) { p0_transpose_item(ap->in[6], 512, D, (bf16*)(ws + WS_WA), 1, scr, r, lane); continue; } r -= I_A;
            if (r < I_A) { p0_transpose_item(ap->in[7], 512, D, (bf16*)(ws + WS_WB), 1, scr, r, lane); continue; } r -= I_A;
            if (r < I_O) { p0_transpose_item(ap->in[8], D, D, (bf16*)(ws + WS_WOUT), 0, scr, r, lane); continue; } r -= I_O;
            p0_transpose_item(ap->in[10], D, 2048, (bf16*)(ws + WS_WQ), 1, scr, r, lane);
        }
        { const float* x = ap->in[0]; const float* g1 = ap->in[1]; bf16* Hb = (bf16*)(ws + WS_H);
          for (int m = gw; m < T; m += NGW) rms_row_to_bf16(lane, x + (size_t)m * D, g1, Hb + (size_t)m * D); }
        const size_t gtid = (size_t)F.vcu * 512 + tid, gth = (size_t)F.G * 512;
        cvt_stream(ap->in[12], (bf16*)(ws + WS_U), (size_t)NEXP * D / 8, gtid, gth);
        cvt_stream(ap->in[13], (bf16*)(ws + WS_V), (size_t)NEXP * D / 8, gtid, gth);
        cvt_stream(ap->in[11], (bf16*)(ws + WS_SUBK), (size_t)16 * 128 * 128 / 8, gtid, gth);
        if (gtid < 1024) { float* TAB = (float*)(ws + WS_TAB); const int pos = (int)gtid >> 4, f = (int)gtid & 15; const float ang = (float)pos * powf(10000.f, -(float)f / 16.f); TAB[gtid] = cosf(ang); TAB[1024 + gtid] = sinf(ang);
            if (gtid < 64) { TAB[2048 + gtid] = ap->in[4][gtid]; TAB[2048 + 64 + gtid] = ap->in[5][gtid]; } }
    }
    xcd_barrier(bar);

    {
        KARGS(ap); unsigned char* ws = ap->ws;
        pg8::Gemm g{(const bf16*)(ws + WS_H), (const bf16*)(ws + WS_WIN), T, INW, D}; pg8::StaticOrder S; S.init(T, INW, F.G, (int)blockIdx.x);
        pg8::EpiProj E{PGG(unsigned char, ws)};
        pg8::gemm_phase<pg8::EpiProj, pg8::StaticOrder, true, true>(F.lds + RING_OFF, g, S, E);
    }
    xcd_barrier(bar);

    {
        using namespace attn_body;
        for (int uid = F.vcu; uid < 1024; uid += F.G) {
            KARGS(ap); unsigned char* ws = ap->ws;
            if (uid < 512) {
                const int bh = uid >> 3, qb = uid & 7, b = bh >> 3, h = bh & 7, kvh = h >> 2;
                const attn_body::bf16* Qu = (const attn_body::bf16*)(ws + WS_QB) + ((size_t)b * SEQ + qb * 256) * 512 + h * 64;
                const attn_body::bf16* Kt = (const attn_body::bf16*)(ws + WS_KB) + ((size_t)b * SEQ) * 128 + kvh * 64;
                const attn_body::bf16* Vt = (const attn_body::bf16*)(ws + WS_VB) + ((size_t)b * SEQ) * 128 + kvh * 64;
                attn_unit<0, 8, 512, 128>(Qu, Kt, Vt, (attn_body::bf16*)Qu, 32, 0, 0, (char*)lds + RING_OFF);
            } else {
                const int v = uid - 512, bh = v >> 3, g = v & 7, b = bh >> 3, h = bh & 7;
                const int krow0 = (g == 0) ? 0 : (g == 7 ? 24 : 4 * g - 4), NT = (g == 0 || g == 7) ? 8 : 12;
                {
                    OPAQUE_TID(tid); const GAS float* rpb = (const GAS float*)ap->in[3];
                    __syncthreads();
                    for (int i = tid; i < 15 * 128; i += NWAVES * 64) { const int dr = i >> 7, xx = (i & 127) - 48;
                        ((LAS float*)(F.lds + RING_OFF + LDS_NATAB))[i] = (xx >= 0 && xx <= 30) ? rpb[(h * 15 + dr) * 31 + xx] * 1.4426950408889634f : 0.f; }
                    __syncthreads();
                }
                const attn_body::bf16* Qu = (const attn_body::bf16*)(ws + WS_QA) + ((size_t)b * SEQ + g * 256) * 512 + h * 64;
                const attn_body::bf16* Kt = (const attn_body::bf16*)(ws + WS_KA) + ((size_t)b * SEQ + krow0 * 64) * 512 + h * 64;
                const attn_body::bf16* Vt = (const attn_body::bf16*)(ws + WS_VA) + ((size_t)b * SEQ + krow0 * 64) * 512 + h * 64;
                attn_unit<1, 8, 512, 512>(Qu, Kt, Vt, (attn_body::bf16*)Qu, NT, 4 * g, krow0, (char*)lds + RING_OFF);
            }
        }
    }
    xcd_barrier(bar);

    {
        KARGS(ap); unsigned char* ws = ap->ws;
        pg8::Gemm g{(const bf16*)(ws + WS_QA), (const bf16*)(ws + WS_WA), T, D, 512}; pg8::StaticOrder S; S.init(T, D, F.G, (int)blockIdx.x);
        pg8::EpiGate<0> E{PGG(const bf16, ws + WS_G), 0, PGG(bf16, ws + WS_MERGED)};
        pg8::gemm_phase<pg8::EpiGate<0>, pg8::StaticOrder, true, true>(F.lds + RING_OFF, g, S, E);
    }
    {
        KARGS(ap); unsigned char* ws = ap->ws;
        pg8::Gemm g{(const bf16*)(ws + WS_QB), (const bf16*)(ws + WS_WB), T, D, 512}; pg8::StaticOrder S; S.init(T, D, F.G, (int)blockIdx.x);
        pg8::EpiGate<1> E{PGG(const bf16, ws + WS_G), 1024, PGG(bf16, ws + WS_MERGED)};
        pg8::gemm_phase<pg8::EpiGate<1>, pg8::StaticOrder, true, true>(F.lds + RING_OFF, g, S, E);
    }
    xcd_barrier(bar);

    {
        KARGS(ap); unsigned char* ws = ap->ws;
        pg8::Gemm g{(const bf16*)(ws + WS_MERGED), (const bf16*)(ws + WS_WOUT), T, D, D}; pg8::StaticOrder S; S.init(T, D, F.G, (int)blockIdx.x);
        pg8::EpiRes E{PGG(const float, ap->in[0]), PGG(float, ap->out)};
        pg8::gemm_phase<pg8::EpiRes, pg8::StaticOrder, true, true>(F.lds + RING_OFF, g, S, E);
    }
    xcd_barrier(bar);

    {
        KARGS(ap); unsigned char* ws = ap->ws; OPAQUE_TID(tid);
        const int lane = tid & 63, gw = F.vcu * NWAVES + __builtin_amdgcn_readfirstlane(tid >> 6), NGW = F.G * NWAVES;
        const float* x1 = ap->out; const float* g2 = ap->in[9]; bf16* XN = (bf16*)(ws + WS_XN);
        for (int m = gw; m < T; m += NGW) rms_row_to_bf16(lane, x1 + (size_t)m * D, g2, XN + (size_t)m * D);
    }
    xcd_barrier(bar);

    {
        KARGS(ap); unsigned char* ws = ap->ws;
        pg8::Gemm g{(const bf16*)(ws + WS_XN), (const bf16*)(ws + WS_WQ), T, 2048, D}; pg8::StaticOrder S; S.init(T, 2048, F.G, (int)blockIdx.x);
        pg8::EpiStore E{PGG(bf16, ws + WS_Q2), 2048};
        pg8::gemm_phase<pg8::EpiStore, pg8::StaticOrder, true, true>(F.lds + RING_OFF, g, S, E);
    }
    xcd_barrier(bar);

    { KARGS(ap); route_phase(F, ap->ws); }
    xcd_barrier(bar);

    { KARGS(ap); expert_phase(F, ap->ws, ap->in[14], ap->out); }
}

extern "C" void kernel_launch(void* const* d_in, const int* in_sizes, int n_in, void* d_out, int out_size, void* d_ws, size_t ws_size, hipStream_t stream) {
    static int grid = 0;
    if (grid == 0) {
        if (n_in != 15 || in_sizes[0] != T * D || out_size != T * D || ws_size < WS_END) { fprintf(stderr, "kernel_launch: unexpected shapes (n_in %d, in0 %d, out %d, ws %zu); nothing launched\n", n_in, n_in > 0 ? in_sizes[0] : -1, out_size, ws_size); grid = -1; return; }
        int dev = 0, cus = 0, per_cu = 0;
        if (hipGetDevice(&dev) != hipSuccess || hipDeviceGetAttribute(&cus, hipDeviceAttributeMultiprocessorCount, dev) != hipSuccess) { fprintf(stderr, "kernel_launch: device query failed\n"); grid = -1; return; }
        if (hipFuncSetAttribute((const void*)mk_fwd, hipFuncAttributeMaxDynamicSharedMemorySize, LDS_BYTES) != hipSuccess) { fprintf(stderr, "kernel_launch: hipFuncSetAttribute failed\n"); grid = -1; return; }
        if (hipOccupancyMaxActiveBlocksPerMultiprocessor(&per_cu, (const void*)mk_fwd, NWAVES * 64, LDS_BYTES) != hipSuccess || per_cu < 1) { fprintf(stderr, "kernel_launch: occupancy query reports %d workgroups per CU\n", per_cu); per_cu = 1; }
        (void)hipGetLastError();
        grid = cus;
        if (grid > 256) grid = 256;
    }
    if (grid < 0) return;
    if (hipMemsetAsync((char*)d_ws + WS_CTL, 0, CTL_ZERO_BYTES, stream) != hipSuccess) { fprintf(stderr, "kernel_launch: hipMemsetAsync failed\n"); return; }
    Args a{};
    for (int i = 0; i < 15; ++i) a.in[i] = (const float*)d_in[i];
    a.out = (float*)d_out; a.ws = (unsigned char*)d_ws;
    hipLaunchKernelGGL(mk_fwd, dim3(grid), dim3(NWAVES * 64), LDS_BYTES, stream, a);
    const hipError_t le = hipPeekAtLastError();
    if (le != hipSuccess) fprintf(stderr, "kernel_launch: launch failed: %s\n", hipGetErrorName(le));
}
```

```cpp
#include <hip/hip_runtime.h>
#include <cstdio>
#include <cstdint>
constexpr int T = 16384, D = 1024, SEQ = 2048, INW = 4352, NEXP = 16384;
constexpr float EPS = 1e-6f;
constexpr size_t MiB = 1u << 20;
constexpr size_t WS_CTL = 0, CTL_ZERO_BYTES = 1 * MiB;
constexpr size_t WS_TAB = 1 * MiB;
constexpr size_t WS_SUBK = 1 * MiB + 65536;
constexpr size_t WS_WIN = 2 * MiB, WS_WA = 11 * MiB, WS_WB = 12 * MiB, WS_WOUT = 13 * MiB, WS_WQ = 15 * MiB;
constexpr size_t WS_U = 20 * MiB, WS_V = 36 * MiB;
constexpr size_t WS_US = 52 * MiB, WS_VS = 52 * MiB + 65536;
constexpr size_t WS_H = 84 * MiB;
constexpr size_t WS_QA = 116 * MiB, WS_KA = 132 * MiB, WS_VA = 148 * MiB;
constexpr size_t WS_QB = 164 * MiB, WS_KB = 180 * MiB, WS_VB = 184 * MiB;
constexpr size_t WS_G = 188 * MiB;
constexpr size_t WS_XN = WS_KA, WS_IDX = WS_QB, WS_GATE = WS_QB + 8 * MiB, WS_Q2 = WS_G, WS_MERGED = WS_H;
constexpr size_t WS_END = 252 * MiB;
constexpr int CW_BAR = 4096;
namespace pg8 {
#define PG8_LAS __attribute__((address_space(3)))
typedef unsigned short bf16_t;
typedef short bf16x8 __attribute__((ext_vector_type(8)));
typedef float f32x4 __attribute__((ext_vector_type(4)));
typedef unsigned u32x4 __attribute__((ext_vector_type(4)));
constexpr int BM = 256, BK = 64, HALF = 128, HTB = HALF * BK * 2  , STAGE_BYTES = 8 * HTB, NXCD = 8, WGM = 8;

__host__ __device__ __forceinline__ int lds_byte(int r, int c) { const int st = (r >> 4) * 2 + (c >> 5), rr = r & 15, cc = c & 31, ob = rr * 64 + cc * 2; return st * 1024 + (ob ^ (((ob >> 9) & 1) << 5)); }
__host__ __device__ __forceinline__ void stage_rc(int b, int& R, int& C) { const int st = b / 1024, sb = b % 1024, swz = sb ^ (((sb >> 9) & 1) << 5); R = (st >> 1) * 16 + swz / 64; C = (st & 1) * 32 + (swz % 64) / 2; }
__host__ __device__ __forceinline__ int perm32(int rho) { const int n = rho >> 4, i = rho & 15; return 8 * (i >> 2) + 4 * n + (i & 3); }

struct Unit { int pm, pn; };
struct Gemm { const bf16_t* A; const bf16_t* Bt; int M, N, K; };

struct StaticOrder {
    int nM, nN, nwg, G, c;
    __host__ __device__ void init(int M, int N, int G_, int c_) { nM = M / BM; nN = N / BM; nwg = nM * nN; G = G_; c = c_; }
    __host__ __device__ bool next(int i, Unit& u) const {
        const long L = (long)i * G + c; if (L >= nwg) return false;
        int wgid = (int)L; { const int q = nwg / NXCD, r = nwg % NXCD, xcd = wgid % NXCD, off = wgid / NXCD; wgid = (xcd < r ? xcd * (q + 1) : r * (q + 1) + (xcd - r) * q) + off; }
        const int nig = WGM * nN, gid = wgid / nig, fm = gid * WGM, gsz = (nM - fm) < WGM ? (nM - fm) : WGM;
        u.pm = fm + ((wgid % nig) % gsz); u.pn = (wgid % nig) / gsz; return true;
    }
    __device__ __forceinline__ void a_ready(const Unit&) const {}
    __device__ __forceinline__ void done(const Unit&) const {}
};
#define PG8_GAS __attribute__((address_space(1)))
__device__ __forceinline__ unsigned cvt_pk_bf16(float lo, float hi) { unsigned r; asm volatile("v_cvt_pk_bf16_f32 %0, %1, %2" : "=v"(r) : "v"(lo), "v"(hi)); return r; }
typedef unsigned u32x2 __attribute__((ext_vector_type(2)));
__device__ __forceinline__ float bf_lo(unsigned w) { return __builtin_bit_cast(float, w << 16); }
__device__ __forceinline__ float bf_hi(unsigned w) { return __builtin_bit_cast(float, w & 0xffff0000u); }
__device__ __forceinline__ float sigm(float v) { return __builtin_amdgcn_rcpf(1.0f + __builtin_amdgcn_exp2f(-1.4426950408889634f * v)); }
constexpr float QC2 = 0.125f * 1.4426950408889634f;

struct EpiProj {
    static constexpr bool PERM = false, AFTER_DRAIN = false;
    PG8_GAS unsigned char* ws;
    __device__ __forceinline__ void operator()(const f32x4 (&acc)[2][2][4][2], const Unit& u, int wr, int wc, int fr, int fq) const {
        const int pn = u.pn, row0 = u.pm * BM + wr * 64 + fr;
        if (pn < 6 || pn >= 9) {
            size_t boff; int pitch, col; float sc = 1.f; const bool sig = pn >= 9;
            if (pn < 6) { boff = WS_QA + (size_t)(pn >> 1) * (WS_KA - WS_QA); pitch = 512; col = (pn & 1) * 256; sc = pn < 2 ? QC2 : 1.f; }
            else { boff = WS_G; pitch = 2048; col = (pn - 9) * 256; }
            PG8_GAS bf16_t* base = (PG8_GAS bf16_t*)(ws + boff);
            col += wc * 32 + 8 * fq;
#pragma unroll
            for (int ai = 0; ai < 2; ++ai)
#pragma unroll
                for (int m = 0; m < 4; ++m) { PG8_GAS bf16_t* rowp = base + (size_t)(row0 + ai * HALF + m * 16) * pitch + col;
#pragma unroll
                    for (int bj = 0; bj < 2; ++bj) { f32x4 v0 = acc[ai][bj][m][0], v1 = acc[ai][bj][m][1];
                        if (sig) { v0 = (f32x4){sigm(v0[0]), sigm(v0[1]), sigm(v0[2]), sigm(v0[3])}; v1 = (f32x4){sigm(v1[0]), sigm(v1[1]), sigm(v1[2]), sigm(v1[3])}; }
                        else { v0 = v0 * sc; v1 = v1 * sc; }
                        u32x4 w; w.x = cvt_pk_bf16(v0[0], v0[1]); w.y = cvt_pk_bf16(v0[2], v0[3]); w.z = cvt_pk_bf16(v1[0], v1[1]); w.w = cvt_pk_bf16(v1[2], v1[3]);
                        *(PG8_GAS u32x4*)(rowp + bj * HALF) = w; } }
        } else {
            size_t boff; int pitch, hcol, goff; bool norm; float sc;
            if (pn < 8) { boff = WS_QB; pitch = 512; hcol = ((pn - 6) * 4 + wc) * 64; norm = true; goff = 2048; sc = QC2; }
            else if (wc < 2) { boff = WS_KB; pitch = 128; hcol = wc * 64; norm = true; goff = 2048 + 64; sc = 1.f; }
            else { boff = WS_VB; pitch = 128; hcol = (wc - 2) * 64; norm = false; goff = 2048; sc = 1.f; }
            PG8_GAS bf16_t* base = (PG8_GAS bf16_t*)(ws + boff);
            const PG8_GAS float* tab = (const PG8_GAS float*)(ws + WS_TAB); const PG8_GAS float* g = tab + goff;
#pragma unroll
            for (int ai = 0; ai < 2; ++ai)
#pragma unroll
                for (int m = 0; m < 4; ++m) { const int row = row0 + ai * HALF + m * 16; PG8_GAS bf16_t* rowp = base + (size_t)row * pitch + hcol + 4 * fq;
                    if (norm) {
                        float ss = 0.f;
#pragma unroll
                        for (int bj = 0; bj < 2; ++bj)
#pragma unroll
                            for (int n = 0; n < 2; ++n) { const f32x4 x = acc[ai][bj][m][n]; ss += (x[0] * x[0] + x[1] * x[1]) + (x[2] * x[2] + x[3] * x[3]); }
                        ss += __shfl_xor(ss, 16); ss += __shfl_xor(ss, 32);
                        const float r = __builtin_amdgcn_rsqf(ss * (1.0f / 64.0f) + 1e-6f) ;
                        const int s = row & 2047;
#pragma unroll
                        for (int bj = 0; bj < 2; ++bj) { const int pos = bj ? (s & 63) : (s >> 6);
                            const f32x4 cs = *(const PG8_GAS f32x4*)(tab + pos * 16 + 4 * fq), sn = *(const PG8_GAS f32x4*)(tab + 1024 + pos * 16 + 4 * fq);
                            const f32x4 g0 = *(const PG8_GAS f32x4*)(g + 32 * bj + 4 * fq), g1 = *(const PG8_GAS f32x4*)(g + 32 * bj + 16 + 4 * fq);
                            const f32x4 y0 = acc[ai][bj][m][0] * r * g0, y1 = acc[ai][bj][m][1] * r * g1;
                            const f32x4 o0 = (y0 * cs - y1 * sn) * sc, o1 = (y1 * cs + y0 * sn) * sc;
                            u32x2 w0, w1; w0.x = cvt_pk_bf16(o0[0], o0[1]); w0.y = cvt_pk_bf16(o0[2], o0[3]); w1.x = cvt_pk_bf16(o1[0], o1[1]); w1.y = cvt_pk_bf16(o1[2], o1[3]);
                            *(PG8_GAS u32x2*)(rowp + 32 * bj) = w0; *(PG8_GAS u32x2*)(rowp + 32 * bj + 16) = w1; }
                    } else {
#pragma unroll
                        for (int bj = 0; bj < 2; ++bj)
#pragma unroll
                            for (int n = 0; n < 2; ++n) { const f32x4 x = acc[ai][bj][m][n]; u32x2 w; w.x = cvt_pk_bf16(x[0], x[1]); w.y = cvt_pk_bf16(x[2], x[3]); *(PG8_GAS u32x2*)(rowp + 32 * bj + 16 * n) = w; }
                    } }
        }
    }
};
template <int MODE> struct EpiGate {
    static constexpr bool PERM = false, AFTER_DRAIN = false;
    const PG8_GAS bf16_t* SG; int gcol0; PG8_GAS bf16_t* Mg;
    __device__ __forceinline__ void operator()(const f32x4 (&acc)[2][2][4][2], const Unit& u, int wr, int wc, int fr, int fq) const {
        const int row0 = u.pm * BM + wr * 64 + fr, col = u.pn * BM + wc * 32 + 8 * fq;
#pragma unroll
        for (int ai = 0; ai < 2; ++ai)
#pragma unroll
            for (int m = 0; m < 4; ++m) { const size_t row = (size_t)(row0 + ai * HALF + m * 16);
#pragma unroll
                for (int bj = 0; bj < 2; ++bj) { const int c = col + bj * HALF;
                    const u32x4 gw = *(const PG8_GAS u32x4*)(SG + row * 2048 + gcol0 + c);
                    f32x4 v0 = acc[ai][bj][m][0], v1 = acc[ai][bj][m][1];
                    v0 = v0 * (f32x4){bf_lo(gw.x), bf_hi(gw.x), bf_lo(gw.y), bf_hi(gw.y)}; v1 = v1 * (f32x4){bf_lo(gw.z), bf_hi(gw.z), bf_lo(gw.w), bf_hi(gw.w)};
                    PG8_GAS u32x4* dst = (PG8_GAS u32x4*)(Mg + row * 1024 + c);
                    if (MODE == 1) { const u32x4 ow = *dst; v0 = v0 + (f32x4){bf_lo(ow.x), bf_hi(ow.x), bf_lo(ow.y), bf_hi(ow.y)}; v1 = v1 + (f32x4){bf_lo(ow.z), bf_hi(ow.z), bf_lo(ow.w), bf_hi(ow.w)}; }
                    u32x4 w; w.x = cvt_pk_bf16(v0[0], v0[1]); w.y = cvt_pk_bf16(v0[2], v0[3]); w.z = cvt_pk_bf16(v1[0], v1[1]); w.w = cvt_pk_bf16(v1[2], v1[3]);
                    *dst = w; } }
    }
};
struct EpiRes {
    static constexpr bool PERM = false, AFTER_DRAIN = false;
    const PG8_GAS float* base; PG8_GAS float* out;
    __device__ __forceinline__ void operator()(const f32x4 (&acc)[2][2][4][2], const Unit& u, int wr, int wc, int fr, int fq) const {
        const int row0 = u.pm * BM + wr * 64 + fr, col = u.pn * BM + wc * 32 + 4 * fq;
#pragma unroll
        for (int ai = 0; ai < 2; ++ai)
#pragma unroll
            for (int m = 0; m < 4; ++m) { const size_t off = (size_t)(row0 + ai * HALF + m * 16) * 1024 + col;
#pragma unroll
                for (int bj = 0; bj < 2; ++bj)
#pragma unroll
                    for (int n = 0; n < 2; ++n) { const f32x4 b = *(const PG8_GAS f32x4*)(base + off + bj * HALF + n * 16); *(PG8_GAS f32x4*)(out + off + bj * HALF + n * 16) = b + acc[ai][bj][m][n]; } }
    }
};
struct EpiStore {
    static constexpr bool PERM = false, AFTER_DRAIN = false;
    PG8_GAS bf16_t* O; int ldc;
    __device__ __forceinline__ void operator()(const f32x4 (&acc)[2][2][4][2], const Unit& u, int wr, int wc, int fr, int fq) const {
        const int row0 = u.pm * BM + wr * 64 + fr, col = u.pn * BM + wc * 32 + 8 * fq;
#pragma unroll
        for (int ai = 0; ai < 2; ++ai)
#pragma unroll
            for (int m = 0; m < 4; ++m) { PG8_GAS bf16_t* rowp = O + (size_t)(row0 + ai * HALF + m * 16) * ldc + col;
#pragma unroll
                for (int bj = 0; bj < 2; ++bj) { const f32x4 v0 = acc[ai][bj][m][0], v1 = acc[ai][bj][m][1];
                    u32x4 w; w.x = cvt_pk_bf16(v0[0], v0[1]); w.y = cvt_pk_bf16(v0[2], v0[3]); w.z = cvt_pk_bf16(v1[0], v1[1]); w.w = cvt_pk_bf16(v1[2], v1[3]);
                    *(PG8_GAS u32x4*)(rowp + bj * HALF) = w; } }
    }
};

template <class Epi, class Sched, bool ALIGN_EPI = false, bool SP2 = false>
__device__ __forceinline__ void gemm_phase(PG8_LAS unsigned char* lds, const Gemm g, const Sched& S, const Epi& E) {
    int tid_ = threadIdx.x; asm volatile("" : "+v"(tid_));
    const int tid = tid_, wid = __builtin_amdgcn_readfirstlane(tid >> 6), lane = tid & 63, wr = wid >> 2, wc = wid & 3, fr = lane & 15, fq = lane >> 4;
    const int K = g.K, nt = K / BK;
    unsigned voffA[2], voffB[2];
#pragma unroll
    for (int i = 0; i < 2; ++i) { int R, C; stage_rc(tid * 16 + i * 8192, R, C); const int Rb = Epi::PERM ? ((R & ~31) + perm32(R & 31)) : R;
        voffA[i] = (unsigned)(R * K + C) * 2u; voffB[i] = (unsigned)(Rb * K + C) * 2u; }
    const size_t kstep = (size_t)(BK * 2);
    const size_t hstep = (size_t)HALF * K * 2;
    const size_t tstep = 2 * hstep;
    const unsigned ldsw = (unsigned)wid * 1024u;
    const int aoff = lds_byte(wr * 64 + fr, fq * 8), boff = lds_byte(wc * 32 + fr, fq * 8);
#define PG8_SA(b, h) (((b) * 2 + (h)) * HTB)
#define PG8_SB(b, h) ((4 + (b) * 2 + (h)) * HTB)
#define PG8_STAGE(bufoff, gbase, voff) do { _Pragma("unroll") for (int _i = 0; _i < 2; ++_i) \
        __builtin_amdgcn_global_load_lds((const unsigned*)((const char*)(gbase) + (voff)[_i]), (PG8_LAS unsigned*)(lds + (bufoff) + ldsw + _i * 8192), 16, 0, 0); } while (0)
#define PG8_LDA(dst, b, h) do { _Pragma("unroll") for (int m = 0; m < 4; ++m) _Pragma("unroll") for (int k = 0; k < 2; ++k) dst[m][k] = *(const PG8_LAS bf16x8*)(lds + PG8_SA(b, h) + aoff + m * 2048 + k * 1024); } while (0)
#define PG8_LDB(dst, b, h) do { _Pragma("unroll") for (int n = 0; n < 2; ++n) _Pragma("unroll") for (int k = 0; k < 2; ++k) dst[n][k] = *(const PG8_LAS bf16x8*)(lds + PG8_SB(b, h) + boff + n * 2048 + k * 1024); } while (0)
#define PG8_MMA(ai, bj, At, Bt) do { __builtin_amdgcn_s_setprio(1); _Pragma("unroll") for (int m = 0; m < 4; ++m) _Pragma("unroll") for (int n = 0; n < 2; ++n) _Pragma("unroll") for (int k = 0; k < 2; ++k) \
        acc[ai][bj][m][n] = __builtin_amdgcn_mfma_f32_16x16x32_bf16(Bt[n][k], At[m][k], acc[ai][bj][m][n], 0, 0, 0); __builtin_amdgcn_s_setprio(0); } while (0)
#define PG8_WAIT_V(n) asm volatile("s_waitcnt vmcnt(" #n ")" ::: "memory")
#define PG8_WAIT_L(n) asm volatile("s_waitcnt lgkmcnt(" #n ")" ::: "memory")
#define PG8_BAR __builtin_amdgcn_s_barrier()
#define PG8_SCHED __builtin_amdgcn_sched_barrier(0)
    Unit cur, nxt; int ui = 0;
    if (!S.next(0, cur)) return;
    f32x4 acc[2][2][4][2];
#pragma unroll
    for (int a = 0; a < 2; ++a)
#pragma unroll
        for (int b = 0; b < 2; ++b)
#pragma unroll
            for (int m = 0; m < 4; ++m)
#pragma unroll
                for (int n = 0; n < 2; ++n) acc[a][b][m][n] = (f32x4){0.f, 0.f, 0.f, 0.f};
    bf16x8 At[4][2], B0[2][2], B1[2][2];
    const char* cA = (const char*)g.A + (size_t)cur.pm * tstep; const char* cB = (const char*)g.Bt + (size_t)cur.pn * tstep;
    S.a_ready(cur);
    if constexpr (SP2) {
        PG8_STAGE(PG8_SB(0, 0), cB, voffB); PG8_STAGE(PG8_SB(0, 1), cB + hstep, voffB); PG8_STAGE(PG8_SA(0, 0), cA, voffA); PG8_STAGE(PG8_SA(0, 1), cA + hstep, voffA);
        if (wr == 1) PG8_BAR;
        PG8_WAIT_V(2); PG8_BAR;
        PG8_STAGE(PG8_SB(1, 0), cB + kstep, voffB); PG8_STAGE(PG8_SA(1, 0), cA + kstep, voffA); PG8_STAGE(PG8_SB(1, 1), cB + hstep + kstep, voffB);
        PG8_WAIT_V(6); PG8_BAR;
    } else {
        PG8_STAGE(PG8_SB(0, 0), cB, voffB); PG8_STAGE(PG8_SA(0, 0), cA, voffA); PG8_STAGE(PG8_SB(0, 1), cB + hstep, voffB); PG8_STAGE(PG8_SA(0, 1), cA + hstep, voffA);
        if (wr == 1) PG8_BAR;
        PG8_WAIT_V(4); PG8_BAR;
        PG8_STAGE(PG8_SB(1, 0), cB + kstep, voffB); PG8_STAGE(PG8_SA(1, 0), cA + kstep, voffA); PG8_STAGE(PG8_SB(1, 1), cB + hstep + kstep, voffB);
        PG8_WAIT_V(6); PG8_BAR;
    }
    for (;;) {
        const bool has_next = S.next(ui + 1, nxt);
        const char* nA = has_next ? (const char*)g.A + (size_t)nxt.pm * tstep : cA; const char* nB = has_next ? (const char*)g.Bt + (size_t)nxt.pn * tstep : cB;
        for (int t = 0; t < nt; t += 2) {
            const bool last = (t == nt - 2);
            const char* a1 = cA + (size_t)(t + 1) * kstep;
            const char* a2 = last ? nA : cA + (size_t)(t + 2) * kstep; const char* b2 = last ? nB : cB + (size_t)(t + 2) * kstep;
            const char* a3 = a2 + kstep; const char* b3 = b2 + kstep;
            if (last && has_next) S.a_ready(nxt);
            if constexpr (SP2) {
            PG8_LDB(B0, 0, 0); PG8_LDB(B1, 0, 1); PG8_SCHED; PG8_LDA(At, 0, 0); PG8_STAGE(PG8_SA(1, 1), a1 + hstep, voffA);
            PG8_WAIT_V(8); PG8_WAIT_L(0); PG8_BAR; PG8_MMA(0, 0, At, B0); PG8_MMA(0, 1, At, B1); PG8_BAR; PG8_SCHED;
            PG8_LDA(At, 0, 1); PG8_STAGE(PG8_SB(0, 0), b2, voffB); PG8_STAGE(PG8_SB(0, 1), b2 + hstep, voffB); PG8_STAGE(PG8_SA(0, 0), a2, voffA);
            PG8_WAIT_V(8); PG8_WAIT_L(0); PG8_BAR; PG8_MMA(1, 0, At, B0); PG8_MMA(1, 1, At, B1); PG8_BAR; PG8_SCHED;
            PG8_LDB(B0, 1, 0); PG8_LDB(B1, 1, 1); PG8_SCHED; PG8_LDA(At, 1, 0); PG8_STAGE(PG8_SA(0, 1), a2 + hstep, voffA);
            PG8_WAIT_V(8); PG8_WAIT_L(0); PG8_BAR; PG8_MMA(0, 0, At, B0); PG8_MMA(0, 1, At, B1); PG8_BAR; PG8_SCHED;
            PG8_LDA(At, 1, 1); PG8_STAGE(PG8_SB(1, 0), b3, voffB); PG8_STAGE(PG8_SB(1, 1), b3 + hstep, voffB); PG8_STAGE(PG8_SA(1, 0), a3, voffA);
            PG8_WAIT_V(8); PG8_WAIT_L(0); PG8_BAR; PG8_MMA(1, 0, At, B0); PG8_MMA(1, 1, At, B1); PG8_BAR; PG8_SCHED;
            } else {
            PG8_LDB(B0, 0, 0); PG8_SCHED; PG8_LDA(At, 0, 0); PG8_STAGE(PG8_SA(1, 1), a1 + hstep, voffA);
            PG8_WAIT_L(8); PG8_BAR; PG8_WAIT_L(0); PG8_MMA(0, 0, At, B0); PG8_BAR; PG8_SCHED;
            PG8_LDB(B1, 0, 1); PG8_STAGE(PG8_SB(0, 0), b2, voffB);
            PG8_BAR; PG8_WAIT_L(0); PG8_MMA(0, 1, At, B1); PG8_BAR;
            PG8_LDA(At, 0, 1); PG8_STAGE(PG8_SA(0, 0), a2, voffA);
            PG8_BAR; PG8_WAIT_L(0); PG8_MMA(1, 0, At, B0); PG8_BAR; PG8_SCHED;
            PG8_STAGE(PG8_SB(0, 1), b2 + hstep, voffB);
            PG8_WAIT_V(6); PG8_BAR; PG8_MMA(1, 1, At, B1); PG8_BAR;
            PG8_LDB(B0, 1, 0); PG8_SCHED; PG8_LDA(At, 1, 0); PG8_STAGE(PG8_SA(0, 1), a2 + hstep, voffA);
            PG8_WAIT_L(8); PG8_BAR; PG8_WAIT_L(0); PG8_MMA(0, 0, At, B0); PG8_BAR; PG8_SCHED;
            PG8_LDB(B1, 1, 1); PG8_STAGE(PG8_SB(1, 0), b3, voffB);
            PG8_BAR; PG8_WAIT_L(0); PG8_MMA(0, 1, At, B1); PG8_BAR;
            PG8_LDA(At, 1, 1); PG8_STAGE(PG8_SA(1, 0), a3, voffA);
            PG8_BAR; PG8_WAIT_L(0); PG8_MMA(1, 0, At, B0); PG8_BAR; PG8_SCHED;
            PG8_STAGE(PG8_SB(1, 1), b3 + hstep, voffB);
            PG8_WAIT_V(6); PG8_BAR; PG8_MMA(1, 1, At, B1); PG8_BAR;
            }
        }
        if constexpr (ALIGN_EPI) { if (wr == 0) PG8_BAR; }
        if constexpr (!Epi::AFTER_DRAIN) { E(acc, cur, wr, wc, fr, fq); S.done(cur); }
        if (!has_next) break;
#pragma unroll
        for (int a = 0; a < 2; ++a)
#pragma unroll
            for (int b = 0; b < 2; ++b)
#pragma unroll
                for (int m = 0; m < 4; ++m)
#pragma unroll
                    for (int n = 0; n < 2; ++n) acc[a][b][m][n] = (f32x4){0.f, 0.f, 0.f, 0.f};
        cur = nxt; cA = nA; cB = nB; ++ui;
        if constexpr (ALIGN_EPI) { if (wr == 1) PG8_BAR; }
    }
    PG8_WAIT_V(0);
    if constexpr (!ALIGN_EPI) { if (wr == 0) PG8_BAR; }
    PG8_BAR;
    if constexpr (Epi::AFTER_DRAIN) { E.fused(acc, cur, wr, wc, fr, fq, lds, wid, lane); S.done(cur); }
#undef PG8_SA
#undef PG8_SB
#undef PG8_STAGE
#undef PG8_LDA
#undef PG8_LDB
#undef PG8_MMA
#undef PG8_WAIT_V
#undef PG8_WAIT_L
#undef PG8_BAR
#undef PG8_SCHED
}
}
#include <hip/hip_bf16.h>
#include <cmath>
namespace attn_body {
using bf16=__hip_bfloat16;
using bf16x8=__attribute__((ext_vector_type(8)))short;
using s16x4=__attribute__((ext_vector_type(4)))short;
using f32x16=__attribute__((ext_vector_type(16)))float;
using u32x4=__attribute__((ext_vector_type(4)))unsigned;
constexpr int D=64;
constexpr int NW=8,QBLK=32,QB=QBLK*NW,KVBLK=64;
__device__ __forceinline__ int crow(int r,int hi){return (r&3)+8*(r>>2)+4*hi;}
#define SBAR() __builtin_amdgcn_sched_barrier(0)
constexpr int NSLOT=3, SLOTB=8192;
constexpr int LDS_K=0, LDS_V=NSLOT*SLOTB, LDS_WS=2*NSLOT*SLOTB, LDS_OST=LDS_WS+NW*64*4, LDS_BYTES=LDS_OST+NW*4096;
constexpr float C2=0.125f*1.4426950408889634f;
__device__ __forceinline__ void glds16(const void*gsrc,unsigned lds_dst){unsigned keep;
  asm volatile("s_mov_b32 %0, m0\n\ts_mov_b32 m0, %2\n\ts_nop 0\n\tglobal_load_lds_dwordx4 %1, off\n\ts_mov_b32 m0, %0":"=&s"(keep):"v"(gsrc),"s"(lds_dst):"memory");}
__device__ __forceinline__ float max3f(float a,float b,float c){float r;asm("v_max3_f32 %0, %1, %2, %3":"=v"(r):"v"(a),"v"(b),"v"(c));return r;}
__device__ __forceinline__ float max2f(float a,float b){float r;asm("v_max_f32_e32 %0, %1, %2":"=v"(r):"v"(a),"v"(b));return r;}
__device__ __forceinline__ float fadd_s(float a,float b){float r;asm("v_add_f32_e32 %0, %1, %2":"=v"(r):"v"(a),"v"(b));return r;}
__device__ __forceinline__ float fsub_s(float a,float b){float r;asm("v_sub_f32_e32 %0, %1, %2":"=v"(r):"v"(a),"v"(b));return r;}
typedef float f32x2_t __attribute__((ext_vector_type(2))); typedef __bf16 bf16x2_t __attribute__((ext_vector_type(2)));
__device__ __forceinline__ unsigned cvtpk_s(float lo,float hi){f32x2_t v={lo,hi};bf16x2_t b=__builtin_convertvector(v,bf16x2_t);return __builtin_bit_cast(unsigned,b);}
#define WAIT_BAR(N) asm volatile("s_waitcnt vmcnt(" #N ") lgkmcnt(0)\n\ts_barrier":::"memory")

__device__ __forceinline__ void qkt(f32x16&p0,f32x16&p1,const char*Kslot,const bf16x8*qr,const f32x16&negm,int r32,int hi){
  const char*kb=Kslot+hi*1024+r32*16;
  #pragma unroll
  for(int d0=0;d0<4;++d0){
    const bf16x8 b0=*reinterpret_cast<const bf16x8*>(kb+d0*2048);
    const bf16x8 b1=*reinterpret_cast<const bf16x8*>(kb+d0*2048+512);
    if(d0==0){p0=__builtin_amdgcn_mfma_f32_32x32x16_bf16(b0,qr[0],negm,0,0,0);p1=__builtin_amdgcn_mfma_f32_32x32x16_bf16(b1,qr[0],negm,0,0,0);}
    else{p0=__builtin_amdgcn_mfma_f32_32x32x16_bf16(b0,qr[d0],p0,0,0,0);p1=__builtin_amdgcn_mfma_f32_32x32x16_bf16(b1,qr[d0],p1,0,0,0);}}
}
typedef __attribute__((address_space(3))) const char* lds_cptr;
typedef short v4i16_t __attribute__((ext_vector_type(4)));
__device__ __forceinline__ void kload8(bf16x8*kf,lds_cptr kp){
  kf[0]=*(const __attribute__((address_space(3))) bf16x8*)(kp);      kf[1]=*(const __attribute__((address_space(3))) bf16x8*)(kp+512);
  kf[2]=*(const __attribute__((address_space(3))) bf16x8*)(kp+2048); kf[3]=*(const __attribute__((address_space(3))) bf16x8*)(kp+2560);
  kf[4]=*(const __attribute__((address_space(3))) bf16x8*)(kp+4096); kf[5]=*(const __attribute__((address_space(3))) bf16x8*)(kp+4608);
  kf[6]=*(const __attribute__((address_space(3))) bf16x8*)(kp+6144); kf[7]=*(const __attribute__((address_space(3))) bf16x8*)(kp+6656);
}
__device__ __forceinline__ void kload2(bf16x8*kf,lds_cptr kp,int j){ kf[2*j]=*(const __attribute__((address_space(3))) bf16x8*)(kp+j*2048); kf[2*j+1]=*(const __attribute__((address_space(3))) bf16x8*)(kp+j*2048+512); }
__device__ __forceinline__ s16x4 vtr(lds_cptr p){ return __builtin_bit_cast(s16x4,__builtin_amdgcn_ds_read_tr16_b64_v4i16((__attribute__((address_space(3))) v4i16_t*)p)); }
__device__ __forceinline__ float rowmax(const f32x16&p0,const f32x16&p1){
  float a=max3f(p0[0],p0[1],p1[0]),b=max3f(p0[2],p0[3],p1[1]);a=max3f(a,p1[2],p1[3]);
  #pragma unroll
  for(int r=4;r<16;r+=4){a=max3f(a,p0[r],p0[r+1]);b=max3f(b,p0[r+2],p0[r+3]);a=max3f(a,p1[r],p1[r+1]);b=max3f(b,p1[r+2],p1[r+3]);}
  const float m=max2f(a,b);
  auto rr=__builtin_amdgcn_permlane32_swap(__float_as_uint(m),__float_as_uint(m),false,false);
  return max2f(__uint_as_float(rr[0]),__uint_as_float(rr[1]));
}
__device__ __forceinline__ void pv(f32x16*o,int vb,bf16x8 pa0,bf16x8 pa1,bf16x8 pa2,bf16x8 pa3){
  #pragma unroll
  for(int d0=0;d0<2;++d0){s16x4 lo[4],hi[4];
    #pragma unroll
    for(int ks=0;ks<4;++ks){
      asm volatile("ds_read_b64_tr_b16 %0,%1 offset:%c2":"=&v"(lo[ks]):"v"(vb),"i"(d0*4096+ks*1024):"memory");
      asm volatile("ds_read_b64_tr_b16 %0,%1 offset:%c2":"=&v"(hi[ks]):"v"(vb),"i"(d0*4096+ks*1024+512):"memory");}
    asm volatile("s_waitcnt lgkmcnt(0)":::"memory");SBAR();
    #define PK(k) (bf16x8){lo[k][0],lo[k][1],lo[k][2],lo[k][3],hi[k][0],hi[k][1],hi[k][2],hi[k][3]}
    o[d0]=__builtin_amdgcn_mfma_f32_32x32x16_bf16(pa0,PK(0),o[d0],0,0,0);
    o[d0]=__builtin_amdgcn_mfma_f32_32x32x16_bf16(pa1,PK(1),o[d0],0,0,0);
    o[d0]=__builtin_amdgcn_mfma_f32_32x32x16_bf16(pa2,PK(2),o[d0],0,0,0);
    o[d0]=__builtin_amdgcn_mfma_f32_32x32x16_bf16(pa3,PK(3),o[d0],0,0,0);
    #undef PK
  }
}

#ifndef ATTN_STORE16
#define ATTN_STORE16(p,v) (*(u32x4*)(p)=(v))
#endif
constexpr int LDS_NATAB=86016;
__device__ __forceinline__ void namask(f32x16&p0,f32x16&p1,int kr,int rs,lds_cptr shm3,int toff,int cb){
  const float NEG=-INFINITY;
  if(kr>=rs&&kr<rs+8){
    const __attribute__((address_space(3))) float*tr=(const __attribute__((address_space(3))) float*)(shm3+LDS_NATAB)+(toff+kr*128);
    #pragma unroll
    for(int r=0;r<16;++r){const int c0=(r&3)+8*(r>>2);
      const float b0=tr[c0],b1=tr[c0+32];
      p0[r]=((unsigned)(c0+cb)<16u)?p0[r]+b0:NEG; p1[r]=((unsigned)(c0+32+cb)<16u)?p1[r]+b1:NEG;}
  }else{
    #pragma unroll
    for(int r=0;r<16;++r){p0[r]=NEG;p1[r]=NEG;}
  }
}
template<int MODE,int THRL,int QP,int KP> __device__ __forceinline__ void attn_unit(const bf16*Qu,const bf16*__restrict__ Kt,const bf16*__restrict__ Vt,bf16*Ou,const int NT,const int rq0,const int krow0,char*shm){
  int tid_=threadIdx.x; asm volatile("":"+v"(tid_)); const int tid=tid_,lane=tid&63,r32=lane&31,hi=lane>>5; const int wid=__builtin_amdgcn_readfirstlane(tid>>6);
  const bf16*Qw=Qu+(long)(wid*QBLK)*QP;
  const bf16*Kh=Kt,*Vh=Vt;
  const unsigned lds0=(unsigned)(uintptr_t)shm;
  float*wsf=(float*)(shm+LDS_WS)+wid*64;
  const bf16*ksrc=Kh+(long)lane*KP+wid*8;
  const bf16*vsrc=Vh+(long)(16*(wid&3)+(lane>>2))*KP+(wid>>2)*32+(lane&3)*8;
  const unsigned kdst=lds0+LDS_K+wid*1024, vdst=lds0+LDS_V+wid*1024;
  #define DMA_K(t,slot) glds16(ksrc+(long)(t)*KVBLK*KP,(unsigned)__builtin_amdgcn_readfirstlane(kdst+(slot)))
  #define DMA_V(t,slot) glds16(vsrc+(long)(t)*KVBLK*KP,(unsigned)__builtin_amdgcn_readfirstlane(vdst+(slot)))
  const int vb0=(int)(lds0+LDS_V)+((lane>>4)&1)*32+(lane&3)*8+(4*hi+((lane&15)>>2))*64;
  const char*Kbase=shm+LDS_K; bf16x8 kf[8];
  const lds_cptr shm3=(lds_cptr)shm; const lds_cptr kp0=shm3+LDS_K+hi*1024+r32*16; const lds_cptr vp0=shm3+LDS_V+((lane>>4)&1)*32+(lane&3)*8+(4*hi+((lane&15)>>2))*64;
  DMA_K(0,0);DMA_V(0,0);DMA_K(1,SLOTB);
  bf16x8 qr[4];
  #pragma unroll
  for(int d0=0;d0<4;++d0)qr[d0]=*reinterpret_cast<const bf16x8*>(&Qw[(long)r32*QP+d0*16+hi*8]);
  float mhat=0.f,l_reg=0.f;f32x16 o[2];o[0]=f32x16{};o[1]=f32x16{};f32x16 negm=f32x16{};asm volatile("":"+v"(negm));
  const int na_rq=rq0+(wid>>1), na_cq=32*(wid&1)+r32; const int na_rs=na_rq<4?0:(na_rq>28?24:na_rq-4); const int na_cs=na_cq<8?0:(na_cq>56?48:na_cq-8);
  const int na_toff=(7-na_rq)*128+63-na_cq+4*hi, na_cb=4*hi-na_cs;
  #define CMASK(P0,P1,t) do{ if constexpr(MODE==1) namask(P0,P1,krow0+(t),na_rs,shm3,na_toff,na_cb); }while(0)
  bool resc=false;
  #define START(P0,P1) do{ const float rm=rowmax(P0,P1); resc=false; \
    { const float dl=(MODE==1)?__builtin_fmaxf(rm,-16.f):rm; mhat=fadd_s(mhat,dl); \
      _Pragma("unroll") for(int r=0;r<16;++r){P0[r]=fsub_s(P0[r],dl);P1[r]=fsub_s(P1[r],dl);} \
      _Pragma("unroll") for(int r=0;r<16;++r)negm[r]=-mhat; asm volatile("":"+v"(negm)); } \
    _Pragma("unroll") for(int r=0;r<16;++r)P0[r]=__builtin_amdgcn_exp2f(P0[r]); }while(0)
  #define RESC() do{ if(resc){ asm volatile("s_waitcnt lgkmcnt(0)":::"memory"); \
      _Pragma("unroll") for(int d_=0;d_<2;++d_) _Pragma("unroll") for(int r=0;r<16;++r)o[d_][r]*=wsf[crow(r,hi)]; } }while(0)
  f32x16 pA0,pA1,pB0,pB1;
  int sl_prev=0,sl_cur=0,sl_next=SLOTB;
  #define ROT() do{sl_prev=sl_cur;sl_cur=sl_next;sl_next=(sl_next==(NSLOT-1)*SLOTB)?0:sl_next+SLOTB;}while(0)
  DMA_K(2,2*SLOTB);
  WAIT_BAR(3);
  qkt(pA0,pA1,Kbase,qr,negm,r32,hi);asm volatile("s_nop 15\n\ts_nop 7":"+v"(pA0),"+v"(pA1));CMASK(pA0,pA1,0);
  START(pA0,pA1);
  _Pragma("unroll") for(int r=0;r<16;++r)pA1[r]=__builtin_amdgcn_exp2f(pA1[r]);
  WAIT_BAR(0);
  DMA_K(3,0);DMA_V(1,SLOTB);
  ROT();
  kload8(kf,kp0+sl_cur);
  WAIT_BAR(2);
  s16x4 vlo[8],vhi[8]; u32x4 pw0,pw1,pw2,pw3;
  #define PKW(P,B) cvtpk_s(P[B],P[B+1])
  #define PAF(k) __builtin_bit_cast(bf16x8,pw##k)
  #define VFR(i) (bf16x8){vlo[i][0],vlo[i][1],vlo[i][2],vlo[i][3],vhi[i][0],vhi[i][1],vhi[i][2],vhi[i][3]}
  #define PIN(x) asm volatile("":"+v"(x))
  #define MX3(a,b,c) __builtin_fmaxf(__builtin_fmaxf((a),(b)),(c))
  #define GAPA(MF,A0,A1,A2,A3,W0,W1,PW) do{ MF; sacc+=A0; sacc+=A1; sacc+=A2; sacc+=A3; PIN(sacc); W0; W1; PIN(PW); SBAR(); }while(0)
  #define EX(v) __builtin_amdgcn_exp2f(v)
  #define GAPB(MF,X,B) do{ MF; X[B]=EX(X[B]); X[B+1]=EX(X[B+1]); X[B+2]=EX(X[B+2]); X[B+3]=EX(X[B+3]); PIN(X); SBAR(); }while(0)
  #define VRD(i) do{ vlo[i]=vtr(vp_+(((i)>>2)*4096+((i)&3)*1024)); vhi[i]=vtr(vp_+(((i)>>2)*4096+((i)&3)*1024+512)); }while(0)
  #define KRD(G,j) do{ if(G){ kload2(kf,kp0+sl_next,j); SBAR(); } }while(0)
  #define STEP(C0,C1,P0,P1,t,GK,GV,GL) do{ SBAR(); \
    const lds_cptr vp_=vp0+sl_prev; \
    VRD(0); SBAR(); float sacc=(P0[0]+P0[1]); \
    GAPA(C0=__builtin_amdgcn_mfma_f32_32x32x16_bf16(kf[0],qr[0],negm,0,0,0), P0[2],P0[3],P0[4],P0[5],     pw0[0]=PKW(P0,0), pw0[1]=PKW(P0,2), pw0); \
    VRD(4); SBAR(); GAPA(C1=__builtin_amdgcn_mfma_f32_32x32x16_bf16(kf[1],qr[0],negm,0,0,0), P0[6],P0[7],P0[8],P0[9],     pw0[2]=PKW(P0,4), pw0[3]=PKW(P0,6), pw0); \
    VRD(1); SBAR(); GAPA(C0=__builtin_amdgcn_mfma_f32_32x32x16_bf16(kf[2],qr[1],C0,0,0,0),   P0[10],P0[11],P0[12],P0[13], pw1[0]=PKW(P0,8), pw1[1]=PKW(P0,10), pw1); \
    VRD(5); SBAR(); GAPA(C1=__builtin_amdgcn_mfma_f32_32x32x16_bf16(kf[3],qr[1],C1,0,0,0),   P0[14],P0[15],P1[0],P1[1],   pw1[2]=PKW(P0,12),pw1[3]=PKW(P0,14), pw1); \
    VRD(2); SBAR(); GAPA(C0=__builtin_amdgcn_mfma_f32_32x32x16_bf16(kf[4],qr[2],C0,0,0,0),   P1[2],P1[3],P1[4],P1[5],     pw2[0]=PKW(P1,0), pw2[1]=PKW(P1,2), pw2); \
    VRD(6); SBAR(); GAPA(C1=__builtin_amdgcn_mfma_f32_32x32x16_bf16(kf[5],qr[2],C1,0,0,0),   P1[6],P1[7],P1[8],P1[9],     pw2[2]=PKW(P1,4), pw2[3]=PKW(P1,6), pw2); \
    VRD(3); SBAR(); GAPA(C0=__builtin_amdgcn_mfma_f32_32x32x16_bf16(kf[6],qr[3],C0,0,0,0),   P1[10],P1[11],P1[12],P1[13], pw3[0]=PKW(P1,8), pw3[1]=PKW(P1,10), pw3); \
    VRD(7); SBAR(); GAPA(C1=__builtin_amdgcn_mfma_f32_32x32x16_bf16(kf[7],qr[3],C1,0,0,0),   P1[14],P1[15],0.f,0.f,       pw3[2]=PKW(P1,12),pw3[3]=PKW(P1,14), pw3); \
    l_reg+=sacc; \
    if(GK){DMA_K((t)+3,sl_cur);} if(GV){DMA_V((t)+1,sl_next);} \
    CMASK(C0,C1,t); \
    { float a=MX3(C0[0],C0[1],C1[0]),b=MX3(C0[2],C0[3],C1[1]); a=MX3(a,C1[2],C1[3]); \
      _Pragma("unroll") for(int r=4;r<16;r+=4){a=MX3(a,C0[r],C0[r+1]);b=MX3(b,C0[r+2],C0[r+3]);a=MX3(a,C1[r],C1[r+1]);b=MX3(b,C1[r+2],C1[r+3]);} \
      float rm=__builtin_fmaxf(a,b); { auto rr=__builtin_amdgcn_permlane32_swap(__float_as_uint(rm),__float_as_uint(rm),false,false); rm=__builtin_fmaxf(__uint_as_float(rr[0]),__uint_as_float(rr[1])); } \
      resc=false; \
      if(__builtin_expect(__any(rm>(float)THRL),0)){ const float dl=__builtin_fmaxf(rm,0.f); mhat+=dl; \
        _Pragma("unroll") for(int r=0;r<16;++r){C0[r]-=dl;C1[r]-=dl;} \
        _Pragma("unroll") for(int r=0;r<16;++r)negm[r]=-mhat; asm volatile("":"+v"(negm)); \
        const float f=__builtin_amdgcn_exp2f(-dl); l_reg*=f; if(hi==0)wsf[r32]=f; resc=true; } } \
    SBAR(); \
    GAPB(o[0]=__builtin_amdgcn_mfma_f32_32x32x16_bf16(PAF(0),VFR(0),o[0],0,0,0), C0,0); \
    GAPB(o[1]=__builtin_amdgcn_mfma_f32_32x32x16_bf16(PAF(0),VFR(4),o[1],0,0,0), C0,4); \
    KRD(GL,0); GAPB(o[0]=__builtin_amdgcn_mfma_f32_32x32x16_bf16(PAF(1),VFR(1),o[0],0,0,0), C0,8); \
    KRD(GL,1); GAPB(o[1]=__builtin_amdgcn_mfma_f32_32x32x16_bf16(PAF(1),VFR(5),o[1],0,0,0), C0,12); \
    KRD(GL,2); GAPB(o[0]=__builtin_amdgcn_mfma_f32_32x32x16_bf16(PAF(2),VFR(2),o[0],0,0,0), C1,0); \
    KRD(GL,3); GAPB(o[1]=__builtin_amdgcn_mfma_f32_32x32x16_bf16(PAF(2),VFR(6),o[1],0,0,0), C1,4); \
    GAPB(o[0]=__builtin_amdgcn_mfma_f32_32x32x16_bf16(PAF(3),VFR(3),o[0],0,0,0), C1,8); \
    GAPB(o[1]=__builtin_amdgcn_mfma_f32_32x32x16_bf16(PAF(3),VFR(7),o[1],0,0,0), C1,12); \
    }while(0)
  int t=1;
  for(;t+5<NT;t+=2){
    STEP(pB0,pB1,pA0,pA1,t,true,true,true);     WAIT_BAR(2); RESC(); ROT();
    STEP(pA0,pA1,pB0,pB1,t+1,true,true,true);   WAIT_BAR(2); RESC(); ROT();
  }
  #define ENDW(tt) do{ if((tt)+3<NT){WAIT_BAR(2);} else if((tt)+2<NT){WAIT_BAR(1);} else {WAIT_BAR(0);} }while(0)
  for(;t+1<NT;t+=2){
    STEP(pB0,pB1,pA0,pA1,t,(t+3<NT),(t+1<NT),(t+1<NT));       ENDW(t);   RESC(); ROT();
    STEP(pA0,pA1,pB0,pB1,t+1,(t+4<NT),(t+2<NT),(t+2<NT));     ENDW(t+1); RESC(); ROT();
  }
  STEP(pB0,pB1,pA0,pA1,NT-1,false,false,false); RESC();
  { float sacc=pB0[0]+pB0[1]; _Pragma("unroll") for(int r=2;r<16;++r)sacc+=pB0[r]; _Pragma("unroll") for(int r=0;r<16;++r)sacc+=pB1[r]; l_reg+=sacc;
    pw0=(u32x4){PKW(pB0,0),PKW(pB0,2),PKW(pB0,4),PKW(pB0,6)};pw1=(u32x4){PKW(pB0,8),PKW(pB0,10),PKW(pB0,12),PKW(pB0,14)};pw2=(u32x4){PKW(pB1,0),PKW(pB1,2),PKW(pB1,4),PKW(pB1,6)};pw3=(u32x4){PKW(pB1,8),PKW(pB1,10),PKW(pB1,12),PKW(pB1,14)};
    SBAR(); pv(o,vb0+sl_cur,PAF(0),PAF(1),PAF(2),PAF(3)); }
  #undef PKW
  #undef PAF
  #undef VFR
  #undef PIN
  #undef MX3
  #undef GAPA
  #undef GAPB
  #undef EX
  #undef VRD
  #undef KRD
  #undef STEP
  #undef ENDW
  {auto rr=__builtin_amdgcn_permlane32_swap(__float_as_uint(l_reg),__float_as_uint(l_reg),false,false);l_reg=__uint_as_float(rr[0])+__uint_as_float(rr[1]);}
  if(hi==0)wsf[32+r32]=l_reg;asm volatile("s_waitcnt lgkmcnt(0)":::"memory");
  float rli[16];
  #pragma unroll
  for(int r=0;r<16;++r)rli[r]=__builtin_amdgcn_rcpf(wsf[32+crow(r,hi)]);
  bf16*Ow=Ou+(long)(wid*QBLK)*QP;
  { bf16*stg=(bf16*)(shm+LDS_OST)+wid*2048;
    #pragma unroll
    for(int r=0;r<16;++r){const int orow=crow(r,hi);
      #pragma unroll
      for(int d0=0;d0<2;++d0)stg[orow*64+d0*32+r32]=__float2bfloat16(o[d0][r]*rli[r]);}
    asm volatile("s_waitcnt lgkmcnt(0)":::"memory");
    #pragma unroll
    for(int i=0;i<4;++i){const int row=i*8+(lane>>3),ch=lane&7; const u32x4 v=*(const u32x4*)(stg+row*64+ch*8); ATTN_STORE16(Ow+(long)row*QP+ch*8,v);} }
  asm volatile("s_waitcnt lgkmcnt(0)\n\ts_barrier":::"memory");
  #undef DMA_K
  #undef DMA_V
  #undef CMASK
  #undef START
  #undef RESC
  #undef ROT
}
}

constexpr int NWAVES = 8;
constexpr int RING_OFF = 0, RING_BYTES = 131072;
constexpr int LDSCTL_OFF = RING_BYTES, MISC_OFF = LDSCTL_OFF + 320;
constexpr int LDS_BYTES = 147456;
static_assert(MISC_OFF + 128 <= LDS_BYTES, "LDS map");

#define GAS __attribute__((address_space(1)))
#define LAS __attribute__((address_space(3)))
typedef unsigned short bf16;
typedef unsigned v4u __attribute__((ext_vector_type(4)));
typedef float f32x4 __attribute__((ext_vector_type(4)));
typedef short bf16x8 __attribute__((ext_vector_type(8)));
typedef GAS unsigned gu32;
typedef GAS unsigned long long gu64;
#define RLX_AGENT __ATOMIC_RELAXED, __HIP_MEMORY_SCOPE_AGENT
#define LDS_WAIT() asm volatile("s_waitcnt lgkmcnt(0)" ::: "memory")
#define VM_WAIT() asm volatile("s_waitcnt vmcnt(0)" ::: "memory")
__device__ __forceinline__ unsigned long long rt() { return __builtin_amdgcn_s_memrealtime(); }
__device__ __forceinline__ unsigned f2bf(float f) { unsigned u = __builtin_bit_cast(unsigned, f); return (u + 0x7fffu + ((u >> 16) & 1u)) >> 16; }
__device__ __forceinline__ unsigned pk2(float lo, float hi) { return f2bf(lo) | (f2bf(hi) << 16); }

#define XB_TMO      128
#define XB_XCNT(j)  (256  + 64 * (j))
#define XB_XSUB(j)  (1280 + 64 * (j))
#define XB_XGEN(j)  (2304 + 64 * (j))
#define XB_TOP      3328
#define XB_TOPGEN   3392
#define XCD_BAR_WORDS 3456
#define XB_SPIN_CAP (1u << 18)

__device__ __forceinline__ unsigned xb_ld(unsigned* p)              { return __hip_atomic_load(p, __ATOMIC_RELAXED, __HIP_MEMORY_SCOPE_AGENT); }
__device__ __forceinline__ unsigned xb_add(unsigned* p, unsigned v) { return __hip_atomic_fetch_add(p, v, __ATOMIC_RELAXED, __HIP_MEMORY_SCOPE_AGENT); }
__device__ __forceinline__ unsigned xb_xcc_id() { return (unsigned)__builtin_amdgcn_s_getreg((3 << 11) | 20) & 0xFu; }
#define XB_SPIN(cond, bar) do { unsigned _sp = 0; while (cond) { __builtin_amdgcn_s_sleep(1); \
    if ((++_sp & 255u) == 0u) { if (xb_ld(&(bar)[XB_TMO])) break; if (_sp > XB_SPIN_CAP) { atomicAdd(&(bar)[XB_TMO], 1u); break; } } } } while (0)

struct XcdBarrier {
    unsigned* bar; unsigned x;
    volatile LAS unsigned* st;
};

__device__ __forceinline__ XcdBarrier xcd_barrier_post(unsigned* bar, volatile LAS unsigned* st) {
    XcdBarrier b; b.bar = bar; b.x = xb_xcc_id(); b.st = st;
    if (threadIdx.x == 0) (void)xb_add(&bar[XB_XCNT(b.x)], 1u);
    return b;
}
__device__ __forceinline__ void xcd_barrier_complete(unsigned* bar, unsigned x, unsigned& nloc, unsigned& nx) {
    const unsigned G = gridDim.x * gridDim.y * gridDim.z;
    unsigned sum, cnt, mine, sp = 0u;
    for (;;) {
        sum = 0u; cnt = 0u; mine = 0u;
#pragma unroll
        for (unsigned j = 0; j < 16; ++j) { const unsigned c = xb_ld(&bar[XB_XCNT(j)]); sum += c; cnt += (c > 0u) ? 1u : 0u; mine = (j == x) ? c : mine; }
        if (sum == G) break;
        __builtin_amdgcn_s_sleep(1);
        if ((++sp & 255u) == 0u) { if (xb_ld(&bar[XB_TMO])) break; if (sp > XB_SPIN_CAP) { atomicAdd(&bar[XB_TMO], 1u); break; } }
    }
    nloc = mine > 0u ? mine : 1u; nx = cnt > 0u ? cnt : 1u;
}

__device__ __forceinline__ void xcd_barrier(const XcdBarrier& b) {
    asm volatile("s_waitcnt vmcnt(0)" ::: "memory");
    __syncthreads();
    if (threadIdx.x == 0) {
        unsigned* bar = b.bar;
        __builtin_amdgcn_s_waitcnt(0);
        unsigned nloc = b.st[0], nx = b.st[1];
        if (nloc == 0u) { xcd_barrier_complete(bar, b.x, nloc, nx); b.st[0] = nloc; b.st[1] = nx; }
        const unsigned old = xb_add(&bar[XB_XSUB(b.x)], 1u);
        const unsigned gen = old / nloc;
        if (old + 1u == (gen + 1u) * nloc) {
            __builtin_amdgcn_fence(__ATOMIC_RELEASE, "agent");
            asm volatile("s_waitcnt vmcnt(0)" ::: "memory");
            const unsigned og = xb_add(&bar[XB_TOP], 1u);
            const unsigned tg = og / nx;
            if (og + 1u == (tg + 1u) * nx) xb_add(&bar[XB_TOPGEN], 1u);
            else XB_SPIN(xb_ld(&bar[XB_TOPGEN]) == tg, bar);
            __builtin_amdgcn_fence(__ATOMIC_ACQUIRE, "agent");
            xb_add(&bar[XB_XGEN(b.x)], 1u);
            asm volatile("s_waitcnt vmcnt(0)" ::: "memory");
        } else {
            XB_SPIN(xb_ld(&bar[XB_XGEN(b.x)]) == gen, bar);
            __builtin_amdgcn_fence(__ATOMIC_ACQUIRE, "agent");
            asm volatile("s_waitcnt vmcnt(0)" ::: "memory");
        }
    }
    __syncthreads();
}

typedef unsigned u32x2g __attribute__((ext_vector_type(2)));
struct Frame {
    LAS unsigned char* lds;
    int vcu, G;
};
#define OPAQUE_TID(tid) int tid = threadIdx.x; asm volatile("" : "+v"(tid))
__device__ __forceinline__ float wave_sum(float v) {
#pragma unroll
    for (int o = 1; o < 64; o <<= 1) v += __shfl_xor(v, o);
    return v;
}
__device__ __forceinline__ int phys_row(int mode, int L) {
    if (mode == 0) return L;
    const int tile = L >> 8, lt = L & 255;
    if (mode == 2 && tile >= 6 && tile <= 8) return (tile << 8) + 128 * ((lt >> 5) & 1) + 32 * (lt >> 6) + (lt & 31);
    const int l = L & 31; return (L & ~31) + 16 * ((l >> 2) & 1) + 4 * (l >> 3) + (l & 3);
}
__device__ __forceinline__ void p0_transpose_item(const float* W, int K, int N, bf16* WT, int mode, LAS float* scr, int item, int lane) {
    const int nblk = N / 32, kb = item / nblk, nb = item % nblk, k0 = 64 * kb, n0 = 32 * nb;
#pragma unroll 8
    for (int i = 0; i < 32; ++i) { const int kk = 2 * i + (lane >> 5); scr[kk * 33 + (lane & 31)] = W[(size_t)(k0 + kk) * N + n0 + (lane & 31)]; }
    LDS_WAIT(); asm volatile("" ::: "memory");
    const int c = lane & 7;
#pragma unroll
    for (int j = 0; j < 4; ++j) { const int n = (lane >> 3) + 8 * j; const LAS float* s = scr + (8 * c) * 33 + n;
        v4u o; o.x = pk2(s[0 * 33], s[1 * 33]); o.y = pk2(s[2 * 33], s[3 * 33]); o.z = pk2(s[4 * 33], s[5 * 33]); o.w = pk2(s[6 * 33], s[7 * 33]);
        *(GAS v4u*)(WT + (size_t)phys_row(mode, n0 + n) * K + k0 + 8 * c) = o; }
    LDS_WAIT(); asm volatile("" ::: "memory");
}
__device__ __forceinline__ void rms_row_to_bf16(int lane, const float* xrow, const float* g, bf16* orow) {
    const GAS f32x4* xr = (const GAS f32x4*)xrow + lane; const GAS f32x4* gr = (const GAS f32x4*)g + lane;
    f32x4 v[4]; float s = 0.f;
#pragma unroll
    for (int j = 0; j < 4; ++j) { v[j] = xr[64 * j]; s += (v[j].x * v[j].x + v[j].y * v[j].y) + (v[j].z * v[j].z + v[j].w * v[j].w); }
    const float rstd = 1.f / sqrtf(wave_sum(s) * (1.f / D) + EPS);
    GAS unsigned long long* o8 = (GAS unsigned long long*)orow + lane;
#pragma unroll
    for (int j = 0; j < 4; ++j) { const f32x4 gg = gr[64 * j]; o8[64 * j] = (unsigned long long)pk2(v[j].x * rstd * gg.x, v[j].y * rstd * gg.y) | ((unsigned long long)pk2(v[j].z * rstd * gg.z, v[j].w * rstd * gg.w) << 32); }
}
__device__ __forceinline__ void cvt_stream(const float* src, bf16* dst, size_t n8, size_t gtid, size_t gthreads) {
    for (size_t i = gtid; i < n8; i += gthreads) { const f32x4 a = ((const GAS f32x4*)src)[2 * i], b = ((const GAS f32x4*)src)[2 * i + 1];
        v4u o; o.x = pk2(a.x, a.y); o.y = pk2(a.z, a.w); o.z = pk2(b.x, b.y); o.w = pk2(b.z, b.w); ((GAS v4u*)dst)[i] = o; }
}

__device__ __forceinline__ float wave_max(float v) {
#pragma unroll
    for (int o = 1; o < 64; o <<= 1) v = fmaxf(v, __shfl_xor(v, o));
    return v;
}
__device__ __forceinline__ void row_to_fp8(int lane, const float* src, unsigned char* dst, float* inv) {
    const GAS f32x4* xr = (const GAS f32x4*)src + lane;
    f32x4 v[4]; float am = 0.f;
#pragma unroll
    for (int j = 0; j < 4; ++j) { v[j] = xr[64 * j]; am = fmaxf(am, fmaxf(fmaxf(fabsf(v[j].x), fabsf(v[j].y)), fmaxf(fabsf(v[j].z), fabsf(v[j].w)))); }
    am = wave_max(am);
    const float s = am > 0.f ? 224.f / am : 1.f;
    v4u o; unsigned w[4];
#pragma unroll
    for (int j = 0; j < 4; ++j) { int p = __builtin_amdgcn_cvt_pk_fp8_f32(v[j].x * s, v[j].y * s, 0, false); p = __builtin_amdgcn_cvt_pk_fp8_f32(v[j].z * s, v[j].w * s, p, true); w[j] = (unsigned)p; }
    o.x = w[0]; o.y = w[1]; o.z = w[2]; o.w = w[3];
    ((GAS v4u*)dst)[lane] = o;
    if (lane == 0) *(GAS float*)inv = am > 0.f ? am * (1.f / 224.f) : 1.f;
}
#define CAND_LIST CAND(0,0,0) CAND(1,0,1) CAND(2,0,2) CAND(3,0,3) CAND(4,0,4) CAND(5,0,5) CAND(6,0,6) CAND(7,0,7) CAND(8,0,8) CAND(9,0,9) CAND(10,0,10) CAND(11,0,11) CAND(12,0,12) CAND(13,0,13) CAND(14,0,14) CAND(15,0,15) CAND(16,1,0) CAND(17,1,1) CAND(18,1,2) CAND(19,1,3) CAND(20,1,4) CAND(21,1,5) CAND(22,1,6) CAND(23,1,7) CAND(24,2,0) CAND(25,2,1) CAND(26,2,2) CAND(27,2,3) CAND(28,2,4) CAND(29,3,0) CAND(30,3,1) CAND(31,3,2) CAND(32,3,3) CAND(33,4,0) CAND(34,4,1) CAND(35,4,2) CAND(36,5,0) CAND(37,5,1) CAND(38,6,0) CAND(39,6,1) CAND(40,7,0) CAND(41,7,1) CAND(42,8,0) CAND(43,9,0) CAND(44,10,0) CAND(45,11,0) CAND(46,12,0) CAND(47,13,0) CAND(48,14,0) CAND(49,15,0)
__device__ __forceinline__ int ford(unsigned bits) { const int k = (int)bits; return k ^ ((k >> 31) & 0x7fffffff); }
__device__ __forceinline__ int imx(int a, int b) { return a > b ? a : b; }
__device__ __forceinline__ int imn(int a, int b) { return a < b ? a : b; }
#define CE_D(a, b) do { const int _x = imx(a, b), _n = imn(a, b); a = _x; b = _n; } while (0)
#define CE_A(a, b) do { const int _x = imx(a, b), _n = imn(a, b); a = _n; b = _x; } while (0)
__device__ __forceinline__ void sort16_desc(int (&v)[16]) {
#pragma unroll
    for (int k = 2; k <= 16; k <<= 1)
#pragma unroll
        for (int j = k >> 1; j > 0; j >>= 1)
#pragma unroll
            for (int i = 0; i < 16; ++i) { const int l = i ^ j; if (l > i) { if ((i & k) == 0) CE_D(v[i], v[l]); else CE_A(v[i], v[l]); } }
}
__device__ __forceinline__ void bmerge16(int (&v)[16]) {
#pragma unroll
    for (int j = 8; j > 0; j >>= 1)
#pragma unroll
        for (int i = 0; i < 16; ++i) { const int l = i ^ j; if (l > i) CE_D(v[i], v[l]); }
}
__device__ __forceinline__ void merge_top16(int (&a)[16], const int (&b)[16]) {
#pragma unroll
    for (int i = 0; i < 16; ++i) a[i] = imx(a[i], b[15 - i]);
    bmerge16(a);
}
__device__ __forceinline__ void top16_of_64(const int (&v)[64], int (&out)[16]) {
    int g1[16], g2[16], g3[16];
#pragma unroll
    for (int i = 0; i < 16; ++i) { out[i] = v[i]; g1[i] = v[16 + i]; g2[i] = v[32 + i]; g3[i] = v[48 + i]; }
    sort16_desc(out); sort16_desc(g1); sort16_desc(g2); sort16_desc(g3);
    merge_top16(out, g1); merge_top16(g2, g3); merge_top16(out, g2);
}
typedef float f32x16v __attribute__((ext_vector_type(16)));
constexpr int RT_SCR = 65536;
__device__ __forceinline__ int mkc(int x, int y, unsigned code) {
    const float fs = __builtin_bit_cast(float, (unsigned)ford((unsigned)x)) + __builtin_bit_cast(float, (unsigned)ford((unsigned)y));
    return ford((__builtin_bit_cast(unsigned, fs) & 0xFFFFFF00u) | code); }
__device__ __forceinline__ void route_phase(const Frame& F, unsigned char* ws) {
    const GAS bf16* SUBK = (const GAS bf16*)(ws + WS_SUBK); const GAS bf16* Q2 = (const GAS bf16*)(ws + WS_Q2);
    GAS int* IDX = (GAS int*)(ws + WS_IDX); GAS float* GATE = (GAS float*)(ws + WS_GATE);
    OPAQUE_TID(tid);
    const int lane = tid & 63, r32 = lane & 31, hi = lane >> 5, wid = __builtin_amdgcn_readfirstlane(tid >> 6);
    int cur_h = -1;
    for (int uid = F.vcu; uid < 8 * (T / 256); uid += F.G) {
        const int hh = uid & 7, tok = (uid >> 3) * 256 + wid * 32 + r32;
        if (hh != cur_h) {
            __syncthreads();
#pragma unroll
            for (int it = 0; it < 8; ++it) { const int id = tid + it * 512, p = id >> 11, n = (id >> 4) & 127, ch = id & 15;
                const v4u w = *(const GAS v4u*)(SUBK + ((size_t)((hh * 2 + p) * 128 + n) * 128 + ch * 8));
                *(LAS v4u*)(F.lds + p * 32768 + ch * 2048 + n * 16) = w; }
            __syncthreads(); cur_h = hh;
        }
        int lst[2][16];
#pragma unroll
        for (int p = 0; p < 2; ++p) {
            f32x16v acc[4];
#pragma unroll
            for (int nt = 0; nt < 4; ++nt) { acc[nt] = (f32x16v){}; asm volatile("" : "+v"(acc[nt])); }
            const GAS bf16* qp = Q2 + (size_t)tok * 2048 + hh * 256 + p * 128 + hi * 8;
            bf16x8 bq[8];
#pragma unroll
            for (int ks = 0; ks < 8; ++ks) bq[ks] = *(const GAS bf16x8*)(qp + ks * 16);
#pragma unroll
            for (int ks = 0; ks < 8; ++ks)
#pragma unroll
                for (int nt = 0; nt < 4; ++nt) { const bf16x8 af = *(const LAS bf16x8*)(F.lds + p * 32768 + (2 * ks + hi) * 2048 + (nt * 32 + r32) * 16);
                    acc[nt] = __builtin_amdgcn_mfma_f32_32x32x16_bf16(af, bq[ks], acc[nt], 0, 0, 0); }
            int v[64];
            const unsigned h4 = (unsigned)hi << 2;
#pragma unroll
            for (int nt = 0; nt < 4; ++nt)
#pragma unroll
                for (int r = 0; r < 16; ++r) { const float sc_ = acc[nt][r];
                    v[nt * 16 + r] = ford((__builtin_bit_cast(unsigned, sc_) & 0xFFFFFF80u) | (unsigned)(32 * nt + (r & 3) + 8 * (r >> 2)) | h4); }
            int mine[16], oth[16];
            top16_of_64(v, mine);
#pragma unroll
            for (int i = 0; i < 16; ++i) oth[i] = __shfl_xor(mine[i], 32);
            merge_top16(mine, oth);
#pragma unroll
            for (int i = 0; i < 16; ++i) lst[p][i] = mine[i];
        }
        LAS unsigned* scr = (LAS unsigned*)(F.lds + RT_SCR + wid * 2048 + lane * 32);
#pragma unroll
        for (int p = 0; p < 2; ++p)
#pragma unroll
            for (int q = 0; q < 4; ++q) { unsigned w = 0;
#pragma unroll
                for (int b = 0; b < 4; ++b) w |= ((unsigned)ford((unsigned)lst[p][4 * q + b]) & 127u) << (8 * b);
                scr[p * 4 + q] = w; }
        int cv[64];
#define CAND(c, i, j) cv[c] = mkc(lst[0][i], lst[1][j], (unsigned)((i) * 16 + (j)));
        CAND_LIST
#undef CAND
#pragma unroll
        for (int c = 50; c < 64; ++c) cv[c] = (int)0x80000000;
        int best[16];
        top16_of_64(cv, best);
        asm volatile("s_waitcnt lgkmcnt(0)" ::: "memory");
        const LAS unsigned char* sb = (const LAS unsigned char*)scr;
        int ex[16]; float gt[16]; float gs = 0.f;
        const float b0 = __builtin_bit_cast(float, (unsigned)ford((unsigned)best[0]));
#pragma unroll
        for (int k = 0; k < 16; ++k) { const unsigned kb = (unsigned)ford((unsigned)best[k]), code = kb & 255u;
            ex[k] = (int)sb[code >> 4] * 128 + (int)sb[16 + (code & 15)];
            gt[k] = __builtin_amdgcn_exp2f((__builtin_bit_cast(float, kb) - b0) * 1.4426950408889634f); gs += gt[k]; }
        const float rg = 1.0f / gs;
        if (hi == 0) {
            GAS v4u* ip = (GAS v4u*)(IDX + (size_t)tok * 128 + hh * 16);
#pragma unroll
            for (int q = 0; q < 4; ++q) ip[q] = (v4u){(unsigned)ex[4 * q], (unsigned)ex[4 * q + 1], (unsigned)ex[4 * q + 2], (unsigned)ex[4 * q + 3]};
        } else {
            GAS f32x4* gp = (GAS f32x4*)(GATE + (size_t)tok * 128 + hh * 16);
#pragma unroll
            for (int q = 0; q < 4; ++q) gp[q] = (f32x4){gt[4 * q] * rg, gt[4 * q + 1] * rg, gt[4 * q + 2] * rg, gt[4 * q + 3] * rg};
        }
    }
    __syncthreads();
}
using pg8::bf_lo; using pg8::bf_hi;
typedef float f32x2v __attribute__((ext_vector_type(2)));
__device__ __forceinline__ float dot16_fp8(const v4u w, const f32x2v (&x)[8]) {
    f32x2v a = __builtin_amdgcn_cvt_pk_f32_fp8((int)w.x, false) * x[0];
    a += __builtin_amdgcn_cvt_pk_f32_fp8((int)w.x, true) * x[1];
    f32x2v b = __builtin_amdgcn_cvt_pk_f32_fp8((int)w.y, false) * x[2];
    b += __builtin_amdgcn_cvt_pk_f32_fp8((int)w.y, true) * x[3];
    a += __builtin_amdgcn_cvt_pk_f32_fp8((int)w.z, false) * x[4];
    b += __builtin_amdgcn_cvt_pk_f32_fp8((int)w.z, true) * x[5];
    a += __builtin_amdgcn_cvt_pk_f32_fp8((int)w.w, false) * x[6];
    b += __builtin_amdgcn_cvt_pk_f32_fp8((int)w.w, true) * x[7];
    a += b; return a.x + a.y;
}
__device__ __forceinline__ void axpy16_fp8(f32x2v (&o)[8], const float hv, const v4u w) {
    const f32x2v h2 = {hv, hv};
    o[0] += h2 * __builtin_amdgcn_cvt_pk_f32_fp8((int)w.x, false); o[1] += h2 * __builtin_amdgcn_cvt_pk_f32_fp8((int)w.x, true);
    o[2] += h2 * __builtin_amdgcn_cvt_pk_f32_fp8((int)w.y, false); o[3] += h2 * __builtin_amdgcn_cvt_pk_f32_fp8((int)w.y, true);
    o[4] += h2 * __builtin_amdgcn_cvt_pk_f32_fp8((int)w.z, false); o[5] += h2 * __builtin_amdgcn_cvt_pk_f32_fp8((int)w.z, true);
    o[6] += h2 * __builtin_amdgcn_cvt_pk_f32_fp8((int)w.w, false); o[7] += h2 * __builtin_amdgcn_cvt_pk_f32_fp8((int)w.w, true);
}
__device__ __forceinline__ float reduce16(const float (&d)[16], int lane) {
    float a[8], b[4], c[2];
    const bool b5 = lane & 32, b4 = lane & 16, b3 = lane & 8, b2 = lane & 4;
#pragma unroll
    for (int i = 0; i < 8; ++i) { const float keep = b5 ? d[8 + i] : d[i], send = b5 ? d[i] : d[8 + i]; a[i] = keep + __shfl_xor(send, 32); }
#pragma unroll
    for (int i = 0; i < 4; ++i) { const float keep = b4 ? a[4 + i] : a[i], send = b4 ? a[i] : a[4 + i]; b[i] = keep + __shfl_xor(send, 16); }
#pragma unroll
    for (int i = 0; i < 2; ++i) { const float keep = b3 ? b[2 + i] : b[i], send = b3 ? b[i] : b[2 + i]; c[i] = keep + __shfl_xor(send, 8); }
    float r = (b2 ? c[1] : c[0]) + __shfl_xor(b2 ? c[0] : c[1], 4);
    r += __shfl_xor(r, 2); r += __shfl_xor(r, 1);
    return r;
}
#define SCHED_PIN() __builtin_amdgcn_sched_barrier(0)
#define ISSUE16(w, TAB, ireg) do { _Pragma("unroll") for (int b_ = 0; b_ < 16; ++b_) { const int row_ = __builtin_amdgcn_readlane(ireg, 4 * b_); \
        w[b_] = *(const GAS v4u*)(TAB + (size_t)row_ * D + 16 * lane); } } while (0)
__device__ __forceinline__ void expert_phase(const Frame& F, unsigned char* ws, const float* gf_, float* out_) {
    const GAS unsigned char* U = (const GAS unsigned char*)(ws + WS_U); const GAS unsigned char* V = (const GAS unsigned char*)(ws + WS_V); const GAS bf16* XN = (const GAS bf16*)(ws + WS_XN);
    const GAS float* US = (const GAS float*)(ws + WS_US); const GAS float* VS = (const GAS float*)(ws + WS_VS);
    const GAS int* IDX = (const GAS int*)(ws + WS_IDX); const GAS float* GATE = (const GAS float*)(ws + WS_GATE);
    const GAS float* gf = (const GAS float*)gf_; GAS float* out = (GAS float*)out_;
    OPAQUE_TID(tid);
    const int lane = tid & 63; const int gw = F.vcu * NWAVES + __builtin_amdgcn_readfirstlane(tid >> 6), NGW = F.G * NWAVES;
    for (int t = gw; t < T; t += NGW) {
        int ix[8]; float hg[8];
#pragma unroll
        for (int be = 0; be < 8; ++be) { ix[be] = IDX[(size_t)t * 128 + 16 * be + (lane >> 2)]; hg[be] = GATE[(size_t)t * 128 + 16 * be + (lane >> 2)]; }
        v4u wa[16], wb[16];
        ISSUE16(wa, U, ix[0]);
        f32x2v x[8];
#pragma unroll
        for (int j = 0; j < 4; ++j) { const u32x2g w = *(const GAS u32x2g*)(XN + (size_t)t * D + 256 * j + 4 * lane); x[2 * j] = (f32x2v){bf_lo(w.x), bf_hi(w.x)}; x[2 * j + 1] = (f32x2v){bf_lo(w.y), bf_hi(w.y)}; }
        float us[8], vs[8];
#pragma unroll
        for (int be = 0; be < 8; ++be) { us[be] = US[ix[be]]; vs[be] = VS[ix[be]]; }
        SCHED_PIN();
        float act[8];
#define ACT_STEP(cur, nxt, be, NEXT_ISSUE) do { NEXT_ISSUE; SCHED_PIN(); float d_[16]; _Pragma("unroll") for (int b_ = 0; b_ < 16; ++b_) d_[b_] = dot16_fp8(cur[b_], x); act[be] = reduce16(d_, lane); SCHED_PIN(); } while (0)
        ACT_STEP(wa, wb, 0, ISSUE16(wb, U, ix[1])); ACT_STEP(wb, wa, 1, ISSUE16(wa, U, ix[2]));
        ACT_STEP(wa, wb, 2, ISSUE16(wb, U, ix[3])); ACT_STEP(wb, wa, 3, ISSUE16(wa, U, ix[4]));
        ACT_STEP(wa, wb, 4, ISSUE16(wb, U, ix[5])); ACT_STEP(wb, wa, 5, ISSUE16(wa, U, ix[6]));
        ACT_STEP(wa, wb, 6, ISSUE16(wb, U, ix[7])); ACT_STEP(wb, wa, 7, ISSUE16(wa, V, ix[0]));
#pragma unroll
        for (int be = 0; be < 8; ++be) { const float a_ = act[be] * us[be]; hg[be] = 0.5f * a_ * (1.f + erff(a_ * 0.70710678118654752f)) * hg[be] * vs[be]; }
        f32x2v o[8];
#pragma unroll
        for (int k = 0; k < 8; ++k) o[k] = (f32x2v){0.f, 0.f};
#define OUT_STEP(cur, nxt, be, NEXT_ISSUE) do { NEXT_ISSUE; SCHED_PIN(); _Pragma("unroll") for (int b_ = 0; b_ < 16; ++b_) { \
            const float hv_ = __builtin_bit_cast(float, __builtin_amdgcn_readlane(__builtin_bit_cast(int, hg[be]), 4 * b_)); axpy16_fp8(o, hv_, cur[b_]); } SCHED_PIN(); } while (0)
        OUT_STEP(wa, wb, 0, ISSUE16(wb, V, ix[1])); OUT_STEP(wb, wa, 1, ISSUE16(wa, V, ix[2]));
        OUT_STEP(wa, wb, 2, ISSUE16(wb, V, ix[3])); OUT_STEP(wb, wa, 3, ISSUE16(wa, V, ix[4]));
        OUT_STEP(wa, wb, 4, ISSUE16(wb, V, ix[5])); OUT_STEP(wb, wa, 5, ISSUE16(wa, V, ix[6]));
        OUT_STEP(wa, wb, 6, ISSUE16(wb, V, ix[7])); OUT_STEP(wb, wa, 7, (void)0);
        GAS f32x4* xr = (GAS f32x4*)(out + (size_t)t * D) + lane;
        f32x4 y[4]; float ss = 0.f;
#pragma unroll
        for (int j = 0; j < 4; ++j) { y[j] = xr[64 * j] + (f32x4){o[2 * j].x, o[2 * j].y, o[2 * j + 1].x, o[2 * j + 1].y}; ss += (y[j].x * y[j].x + y[j].y * y[j].y) + (y[j].z * y[j].z + y[j].w * y[j].w); }
        const float r = 1.f / sqrtf(wave_sum(ss) * (1.f / D) + EPS);
        const GAS f32x4* gr = (const GAS f32x4*)gf + lane;
#pragma unroll
        for (int j = 0; j < 4; ++j) xr[64 * j] = y[j] * r * gr[64 * j];
#ifdef PROBE_PT
        if (t == 0 && lane == 0) { const unsigned long long dt = ((const GAS unsigned long long*)(ws + WS_CTL))[1025]; out[0] += (float)dt * (1.0f / PROBE_DIV); }
#endif
    }
}
struct Args { const float* in[15]; float* out; unsigned char* ws; };
#define KARGS(ap) const __attribute__((address_space(4))) Args* ap; { auto kp_ = __builtin_amdgcn_kernarg_segment_ptr(); asm volatile("" : "+s"(kp_)); ap = (const __attribute__((address_space(4))) Args*)kp_; }
#define PGG(T_, p) ((PG8_GAS T_*)(p))
__global__ void __launch_bounds__(NWAVES * 64, 2) mk_fwd(Args args) {
    extern __shared__ __attribute__((aligned(16))) unsigned char lds[];
    Frame F;
    F.lds = (LAS unsigned char*)lds;
    F.G = gridDim.x; { const int bx = blockIdx.x; F.vcu = (F.G % 8 == 0) ? (bx % 8) * (F.G / 8) + bx / 8 : bx; }
    XcdBarrier bar;
    {
        OPAQUE_TID(tid);
        for (int u = tid; u < (LDS_BYTES - LDSCTL_OFF) / 4; u += NWAVES * 64) ((LAS unsigned*)(F.lds + LDSCTL_OFF))[u] = 0u;
        __syncthreads();
        bar = xcd_barrier_post((unsigned*)(args.ws + WS_CTL) + CW_BAR, (volatile LAS unsigned*)(F.lds + MISC_OFF) + 8);
    }
#ifdef PROBE_PT
    if (blockIdx.x == 0 && threadIdx.x == 0) ((unsigned long long*)(args.ws + WS_CTL))[1024] = __builtin_amdgcn_s_memrealtime();
#define STAMP(k) do { if ((k) == PROBE_PT && blockIdx.x == 0 && threadIdx.x == 0) { unsigned long long* tp = (unsigned long long*)(args.ws + WS_CTL) + 1024; tp[1] = __builtin_amdgcn_s_memrealtime() - tp[0]; } } while (0)
#else
#define STAMP(k) do {} while (0)
#endif

    {
        KARGS(ap); unsigned char* ws = ap->ws; OPAQUE_TID(tid);
        const int lane = tid & 63, wave = __builtin_amdgcn_readfirstlane(tid >> 6), gw = F.vcu * NWAVES + wave, NGW = F.G * NWAVES;
        LAS float* scr = (LAS float*)(F.lds + RING_OFF + wave * 16384);
        constexpr int I_IN = (D / 64) * (INW / 32), I_A = (512 / 64) * (D / 32), I_O = (D / 64) * (D / 32), I_Q = (D / 64) * (2048 / 32);
        constexpr int NITEMS = I_IN + 2 * I_A + I_O + I_Q;
        for (int it = gw; it < NITEMS; it += NGW) {
            int r = it;
            if (r < I_IN) { p0_transpose_item(ap->in[2], D, INW, (bf16*)(ws + WS_WIN), 2, scr, r, lane); continue; } r -= I_IN;
            if (r < I_A) { p0_transpose_item(ap->in[6], 512, D, (bf16*)(ws + WS_WA), 1, scr, r, lane); continue; } r -= I_A;
            if (r < I_A) { p0_transpose_item(ap->in[7], 512, D, (bf16*)(ws + WS_WB), 1, scr, r, lane); continue; } r -= I_A;
            if (r < I_O) { p0_transpose_item(ap->in[8], D, D, (bf16*)(ws + WS_WOUT), 0, scr, r, lane); continue; } r -= I_O;
            p0_transpose_item(ap->in[10], D, 2048, (bf16*)(ws + WS_WQ), 1, scr, r, lane);
        }
        { const float* x = ap->in[0]; const float* g1 = ap->in[1]; bf16* Hb = (bf16*)(ws + WS_H);
          for (int m = gw; m < T; m += NGW) rms_row_to_bf16(lane, x + (size_t)m * D, g1, Hb + (size_t)m * D); }
        const size_t gtid = (size_t)F.vcu * 512 + tid, gth = (size_t)F.G * 512;
        for (int r = gw; r < 2 * NEXP; r += NGW) { const int tb = r >= NEXP, row = r - tb * NEXP;
            row_to_fp8(lane, (tb ? ap->in[13] : ap->in[12]) + (size_t)row * D, ws + (tb ? WS_V : WS_U) + (size_t)row * D, (float*)(ws + (tb ? WS_VS : WS_US)) + row); }
        cvt_stream(ap->in[11], (bf16*)(ws + WS_SUBK), (size_t)16 * 128 * 128 / 8, gtid, gth);
        if (gtid < 1024) { float* TAB = (float*)(ws + WS_TAB); const int pos = (int)gtid >> 4, f = (int)gtid & 15; const float ang = (float)pos * powf(10000.f, -(float)f / 16.f); TAB[gtid] = cosf(ang); TAB[1024 + gtid] = sinf(ang);
            if (gtid < 64) { TAB[2048 + gtid] = ap->in[4][gtid]; TAB[2048 + 64 + gtid] = ap->in[5][gtid]; } }
    }
    xcd_barrier(bar);
    STAMP(0);

    {
        KARGS(ap); unsigned char* ws = ap->ws;
        pg8::Gemm g{(const bf16*)(ws + WS_H), (const bf16*)(ws + WS_WIN), T, INW, D}; pg8::StaticOrder S; S.init(T, INW, F.G, (int)blockIdx.x);
        pg8::EpiProj E{PGG(unsigned char, ws)};
        pg8::gemm_phase<pg8::EpiProj, pg8::StaticOrder, true, true>(F.lds + RING_OFF, g, S, E);
    }
    xcd_barrier(bar);
    STAMP(1);

    {
        using namespace attn_body;
        for (int uid = F.vcu; uid < 1024; uid += F.G) {
            KARGS(ap); unsigned char* ws = ap->ws;
            if (uid < 512) {
                const int bh = uid >> 3, qb = uid & 7, b = bh >> 3, h = bh & 7, kvh = h >> 2;
                const attn_body::bf16* Qu = (const attn_body::bf16*)(ws + WS_QB) + ((size_t)b * SEQ + qb * 256) * 512 + h * 64;
                const attn_body::bf16* Kt = (const attn_body::bf16*)(ws + WS_KB) + ((size_t)b * SEQ) * 128 + kvh * 64;
                const attn_body::bf16* Vt = (const attn_body::bf16*)(ws + WS_VB) + ((size_t)b * SEQ) * 128 + kvh * 64;
                attn_unit<0, 8, 512, 128>(Qu, Kt, Vt, (attn_body::bf16*)Qu, 32, 0, 0, (char*)lds + RING_OFF);
            } else {
                const int v = uid - 512, bh = v >> 3, g = v & 7, b = bh >> 3, h = bh & 7;
                const int krow0 = (g == 0) ? 0 : (g == 7 ? 24 : 4 * g - 4), NT = (g == 0 || g == 7) ? 8 : 12;
                {
                    OPAQUE_TID(tid); const GAS float* rpb = (const GAS float*)ap->in[3];
                    __syncthreads();
                    for (int i = tid; i < 15 * 128; i += NWAVES * 64) { const int dr = i >> 7, xx = (i & 127) - 48;
                        ((LAS float*)(F.lds + RING_OFF + LDS_NATAB))[i] = (xx >= 0 && xx <= 30) ? rpb[(h * 15 + dr) * 31 + xx] * 1.4426950408889634f : 0.f; }
                    __syncthreads();
                }
                const attn_body::bf16* Qu = (const attn_body::bf16*)(ws + WS_QA) + ((size_t)b * SEQ + g * 256) * 512 + h * 64;
                const attn_body::bf16* Kt = (const attn_body::bf16*)(ws + WS_KA) + ((size_t)b * SEQ + krow0 * 64) * 512 + h * 64;
                const attn_body::bf16* Vt = (const attn_body::bf16*)(ws + WS_VA) + ((size_t)b * SEQ + krow0 * 64) * 512 + h * 64;
                attn_unit<1, 8, 512, 512>(Qu, Kt, Vt, (attn_body::bf16*)Qu, NT, 4 * g, krow0, (char*)lds + RING_OFF);
            }
        }
    }
    xcd_barrier(bar);
    STAMP(2);

    {
        KARGS(ap); unsigned char* ws = ap->ws;
        pg8::Gemm g{(const bf16*)(ws + WS_QA), (const bf16*)(ws + WS_WA), T, D, 512}; pg8::StaticOrder S; S.init(T, D, F.G, (int)blockIdx.x);
        pg8::EpiGate<0> E{PGG(const bf16, ws + WS_G), 0, PGG(bf16, ws + WS_MERGED)};
        pg8::gemm_phase<pg8::EpiGate<0>, pg8::StaticOrder, true, true>(F.lds + RING_OFF, g, S, E);
    }
    {
        KARGS(ap); unsigned char* ws = ap->ws;
        pg8::Gemm g{(const bf16*)(ws + WS_QB), (const bf16*)(ws + WS_WB), T, D, 512}; pg8::StaticOrder S; S.init(T, D, F.G, (int)blockIdx.x);
        pg8::EpiGate<1> E{PGG(const bf16, ws + WS_G), 1024, PGG(bf16, ws + WS_MERGED)};
        pg8::gemm_phase<pg8::EpiGate<1>, pg8::StaticOrder, true, true>(F.lds + RING_OFF, g, S, E);
    }
    xcd_barrier(bar);
    STAMP(3);

    {
        KARGS(ap); unsigned char* ws = ap->ws;
        pg8::Gemm g{(const bf16*)(ws + WS_MERGED), (const bf16*)(ws + WS_WOUT), T, D, D}; pg8::StaticOrder S; S.init(T, D, F.G, (int)blockIdx.x);
        pg8::EpiRes E{PGG(const float, ap->in[0]), PGG(float, ap->out)};
        pg8::gemm_phase<pg8::EpiRes, pg8::StaticOrder, true, true>(F.lds + RING_OFF, g, S, E);
    }
    xcd_barrier(bar);
    STAMP(4);

    {
        KARGS(ap); unsigned char* ws = ap->ws; OPAQUE_TID(tid);
        const int lane = tid & 63, gw = F.vcu * NWAVES + __builtin_amdgcn_readfirstlane(tid >> 6), NGW = F.G * NWAVES;
        const float* x1 = ap->out; const float* g2 = ap->in[9]; bf16* XN = (bf16*)(ws + WS_XN);
        for (int m = gw; m < T; m += NGW) rms_row_to_bf16(lane, x1 + (size_t)m * D, g2, XN + (size_t)m * D);
    }
    xcd_barrier(bar);
    STAMP(5);

    {
        KARGS(ap); unsigned char* ws = ap->ws;
        pg8::Gemm g{(const bf16*)(ws + WS_XN), (const bf16*)(ws + WS_WQ), T, 2048, D}; pg8::StaticOrder S; S.init(T, 2048, F.G, (int)blockIdx.x);
        pg8::EpiStore E{PGG(bf16, ws + WS_Q2), 2048};
        pg8::gemm_phase<pg8::EpiStore, pg8::StaticOrder, true, true>(F.lds + RING_OFF, g, S, E);
    }
    xcd_barrier(bar);
    STAMP(6);

    { KARGS(ap); route_phase(F, ap->ws); }
    xcd_barrier(bar);
    STAMP(7);

    { KARGS(ap); expert_phase(F, ap->ws, ap->in[14], ap->out); }
}

extern "C" void kernel_launch(void* const* d_in, const int* in_sizes, int n_in, void* d_out, int out_size, void* d_ws, size_t ws_size, hipStream_t stream) {
    static int grid = 0;
    if (grid == 0) {
        if (n_in != 15 || in_sizes[0] != T * D || out_size != T * D || ws_size < WS_END) { fprintf(stderr, "kernel_launch: unexpected shapes (n_in %d, in0 %d, out %d, ws %zu); nothing launched\n", n_in, n_in > 0 ? in_sizes[0] : -1, out_size, ws_size); grid = -1; return; }
        int dev = 0, cus = 0, per_cu = 0;
        if (hipGetDevice(&dev) != hipSuccess || hipDeviceGetAttribute(&cus, hipDeviceAttributeMultiprocessorCount, dev) != hipSuccess) { fprintf(stderr, "kernel_launch: device query failed\n"); grid = -1; return; }
        if (hipFuncSetAttribute((const void*)mk_fwd, hipFuncAttributeMaxDynamicSharedMemorySize, LDS_BYTES) != hipSuccess) { fprintf(stderr, "kernel_launch: hipFuncSetAttribute failed\n"); grid = -1; return; }
        if (hipOccupancyMaxActiveBlocksPerMultiprocessor(&per_cu, (const void*)mk_fwd, NWAVES * 64, LDS_BYTES) != hipSuccess || per_cu < 1) { fprintf(stderr, "kernel_launch: occupancy query reports %d workgroups per CU\n", per_cu); per_cu = 1; }
        (void)hipGetLastError();
        grid = cus;
        if (grid > 256) grid = 256;
    }
    if (grid < 0) return;
    if (hipMemsetAsync((char*)d_ws + WS_CTL, 0, CTL_ZERO_BYTES, stream) != hipSuccess) { fprintf(stderr, "kernel_launch: hipMemsetAsync failed\n"); return; }
    Args a{};
    for (int i = 0; i < 15; ++i) a.in[i] = (const float*)d_in[i];
    a.out = (float*)d_out; a.ws = (unsigned char*)d_ws;
    hipLaunchKernelGGL(mk_fwd, dim3(grid), dim3(NWAVES * 64), LDS_BYTES, stream, a);
    const hipError_t le = hipPeekAtLastError();
    if (le != hipSuccess) fprintf(stderr, "kernel_launch: launch failed: %s\n", hipGetErrorName(le));
}
```

```cpp
#include <hip/hip_runtime.h>
#include <cstdio>
#include <cstdint>
constexpr int T = 16384, D = 1024, SEQ = 2048, INW = 4352, NEXP = 16384;
constexpr float EPS = 1e-6f;
constexpr size_t MiB = 1u << 20;
constexpr size_t WS_CTL = 0, CTL_ZERO_BYTES = 1 * MiB;
constexpr size_t WS_TAB = 1 * MiB;
constexpr size_t WS_SUBK = 1 * MiB + 65536;
constexpr size_t WS_WIN = 2 * MiB, WS_WA = 11 * MiB, WS_WB = 12 * MiB, WS_WOUT = 13 * MiB, WS_WQ = 15 * MiB;
constexpr size_t WS_U = 20 * MiB, WS_V = 36 * MiB;
constexpr size_t WS_US = 52 * MiB, WS_VS = 52 * MiB + 65536;
constexpr size_t WS_H = 84 * MiB;
constexpr size_t WS_QA = 116 * MiB, WS_KA = 132 * MiB, WS_VA = 148 * MiB;
constexpr size_t WS_QB = 164 * MiB, WS_KB = 180 * MiB, WS_VB = 184 * MiB;
constexpr size_t WS_G = 188 * MiB;
constexpr size_t WS_XN = WS_KA, WS_IDX = WS_QB, WS_GATE = WS_QB + 8 * MiB, WS_Q2 = WS_G, WS_MERGED = WS_H;
constexpr size_t WS_ACT = 54 * MiB;
constexpr size_t WS_SKEY = 62 * MiB;
constexpr size_t WS_END = 252 * MiB;
constexpr int CW_BAR = 4096;
namespace pg8 {
#define PG8_LAS __attribute__((address_space(3)))
typedef unsigned short bf16_t;
typedef short bf16x8 __attribute__((ext_vector_type(8)));
typedef float f32x4 __attribute__((ext_vector_type(4)));
typedef unsigned u32x4 __attribute__((ext_vector_type(4)));
constexpr int BM = 256, BK = 64, HALF = 128, HTB = HALF * BK * 2  , STAGE_BYTES = 8 * HTB, NXCD = 8, WGM = 8;

__host__ __device__ __forceinline__ int lds_byte(int r, int c) { const int st = (r >> 4) * 2 + (c >> 5), rr = r & 15, cc = c & 31, ob = rr * 64 + cc * 2; return st * 1024 + (ob ^ (((ob >> 9) & 1) << 5)); }
__host__ __device__ __forceinline__ void stage_rc(int b, int& R, int& C) { const int st = b / 1024, sb = b % 1024, swz = sb ^ (((sb >> 9) & 1) << 5); R = (st >> 1) * 16 + swz / 64; C = (st & 1) * 32 + (swz % 64) / 2; }
__host__ __device__ __forceinline__ int perm32(int rho) { const int n = rho >> 4, i = rho & 15; return 8 * (i >> 2) + 4 * n + (i & 3); }

struct Unit { int pm, pn; };
struct Gemm { const bf16_t* A; const bf16_t* Bt; int M, N, K; };

struct StaticOrder {
    int nM, nN, nwg, G, c;
    __host__ __device__ void init(int M, int N, int G_, int c_) { nM = M / BM; nN = N / BM; nwg = nM * nN; G = G_; c = c_; }
    __host__ __device__ bool next(int i, Unit& u) const {
        const long L = (long)i * G + c; if (L >= nwg) return false;
        int wgid = (int)L; { const int q = nwg / NXCD, r = nwg % NXCD, xcd = wgid % NXCD, off = wgid / NXCD; wgid = (xcd < r ? xcd * (q + 1) : r * (q + 1) + (xcd - r) * q) + off; }
        const int nig = WGM * nN, gid = wgid / nig, fm = gid * WGM, gsz = (nM - fm) < WGM ? (nM - fm) : WGM;
        u.pm = fm + ((wgid % nig) % gsz); u.pn = (wgid % nig) / gsz; return true;
    }
    __device__ __forceinline__ void a_ready(const Unit&) const {}
    __device__ __forceinline__ void done(const Unit&) const {}
};
#define PG8_GAS __attribute__((address_space(1)))
__device__ __forceinline__ unsigned cvt_pk_bf16(float lo, float hi) { unsigned r; asm volatile("v_cvt_pk_bf16_f32 %0, %1, %2" : "=v"(r) : "v"(lo), "v"(hi)); return r; }
typedef unsigned u32x2 __attribute__((ext_vector_type(2)));
__device__ __forceinline__ float bf_lo(unsigned w) { return __builtin_bit_cast(float, w << 16); }
__device__ __forceinline__ float bf_hi(unsigned w) { return __builtin_bit_cast(float, w & 0xffff0000u); }
__device__ __forceinline__ float sigm(float v) { return __builtin_amdgcn_rcpf(1.0f + __builtin_amdgcn_exp2f(-1.4426950408889634f * v)); }
constexpr float QC2 = 0.125f * 1.4426950408889634f;

struct EpiProj {
    static constexpr bool PERM = false, AFTER_DRAIN = false;
    PG8_GAS unsigned char* ws;
    __device__ __forceinline__ void operator()(const f32x4 (&acc)[2][2][4][2], const Unit& u, int wr, int wc, int fr, int fq) const {
        const int pn = u.pn, row0 = u.pm * BM + wr * 64 + fr;
        if (pn < 6 || pn >= 9) {
            size_t boff; int pitch, col; float sc = 1.f; const bool sig = pn >= 9;
            if (pn < 6) { boff = WS_QA + (size_t)(pn >> 1) * (WS_KA - WS_QA); pitch = 512; col = (pn & 1) * 256; sc = pn < 2 ? QC2 : 1.f; }
            else { boff = WS_G; pitch = 2048; col = (pn - 9) * 256; }
            PG8_GAS bf16_t* base = (PG8_GAS bf16_t*)(ws + boff);
            col += wc * 32 + 8 * fq;
#pragma unroll
            for (int ai = 0; ai < 2; ++ai)
#pragma unroll
                for (int m = 0; m < 4; ++m) { PG8_GAS bf16_t* rowp = base + (size_t)(row0 + ai * HALF + m * 16) * pitch + col;
#pragma unroll
                    for (int bj = 0; bj < 2; ++bj) { f32x4 v0 = acc[ai][bj][m][0], v1 = acc[ai][bj][m][1];
                        if (sig) { v0 = (f32x4){sigm(v0[0]), sigm(v0[1]), sigm(v0[2]), sigm(v0[3])}; v1 = (f32x4){sigm(v1[0]), sigm(v1[1]), sigm(v1[2]), sigm(v1[3])}; }
                        else { v0 = v0 * sc; v1 = v1 * sc; }
                        u32x4 w; w.x = cvt_pk_bf16(v0[0], v0[1]); w.y = cvt_pk_bf16(v0[2], v0[3]); w.z = cvt_pk_bf16(v1[0], v1[1]); w.w = cvt_pk_bf16(v1[2], v1[3]);
                        *(PG8_GAS u32x4*)(rowp + bj * HALF) = w; } }
        } else {
            size_t boff; int pitch, hcol, goff; bool norm; float sc;
            if (pn < 8) { boff = WS_QB; pitch = 512; hcol = ((pn - 6) * 4 + wc) * 64; norm = true; goff = 2048; sc = QC2; }
            else if (wc < 2) { boff = WS_KB; pitch = 128; hcol = wc * 64; norm = true; goff = 2048 + 64; sc = 1.f; }
            else { boff = WS_VB; pitch = 128; hcol = (wc - 2) * 64; norm = false; goff = 2048; sc = 1.f; }
            PG8_GAS bf16_t* base = (PG8_GAS bf16_t*)(ws + boff);
            const PG8_GAS float* tab = (const PG8_GAS float*)(ws + WS_TAB); const PG8_GAS float* g = tab + goff;
#pragma unroll
            for (int ai = 0; ai < 2; ++ai)
#pragma unroll
                for (int m = 0; m < 4; ++m) { const int row = row0 + ai * HALF + m * 16; PG8_GAS bf16_t* rowp = base + (size_t)row * pitch + hcol + 4 * fq;
                    if (norm) {
                        float ss = 0.f;
#pragma unroll
                        for (int bj = 0; bj < 2; ++bj)
#pragma unroll
                            for (int n = 0; n < 2; ++n) { const f32x4 x = acc[ai][bj][m][n]; ss += (x[0] * x[0] + x[1] * x[1]) + (x[2] * x[2] + x[3] * x[3]); }
                        ss += __shfl_xor(ss, 16); ss += __shfl_xor(ss, 32);
                        const float r = __builtin_amdgcn_rsqf(ss * (1.0f / 64.0f) + 1e-6f) ;
                        const int s = row & 2047;
#pragma unroll
                        for (int bj = 0; bj < 2; ++bj) { const int pos = bj ? (s & 63) : (s >> 6);
                            const f32x4 cs = *(const PG8_GAS f32x4*)(tab + pos * 16 + 4 * fq), sn = *(const PG8_GAS f32x4*)(tab + 1024 + pos * 16 + 4 * fq);
                            const f32x4 g0 = *(const PG8_GAS f32x4*)(g + 32 * bj + 4 * fq), g1 = *(const PG8_GAS f32x4*)(g + 32 * bj + 16 + 4 * fq);
                            const f32x4 y0 = acc[ai][bj][m][0] * r * g0, y1 = acc[ai][bj][m][1] * r * g1;
                            const f32x4 o0 = (y0 * cs - y1 * sn) * sc, o1 = (y1 * cs + y0 * sn) * sc;
                            u32x2 w0, w1; w0.x = cvt_pk_bf16(o0[0], o0[1]); w0.y = cvt_pk_bf16(o0[2], o0[3]); w1.x = cvt_pk_bf16(o1[0], o1[1]); w1.y = cvt_pk_bf16(o1[2], o1[3]);
                            *(PG8_GAS u32x2*)(rowp + 32 * bj) = w0; *(PG8_GAS u32x2*)(rowp + 32 * bj + 16) = w1; }
                    } else {
#pragma unroll
                        for (int bj = 0; bj < 2; ++bj)
#pragma unroll
                            for (int n = 0; n < 2; ++n) { const f32x4 x = acc[ai][bj][m][n]; u32x2 w; w.x = cvt_pk_bf16(x[0], x[1]); w.y = cvt_pk_bf16(x[2], x[3]); *(PG8_GAS u32x2*)(rowp + 32 * bj + 16 * n) = w; }
                    } }
        }
    }
};
template <int MODE> struct EpiGate {
    static constexpr bool PERM = false, AFTER_DRAIN = false;
    const PG8_GAS bf16_t* SG; int gcol0; PG8_GAS bf16_t* Mg;
    __device__ __forceinline__ void operator()(const f32x4 (&acc)[2][2][4][2], const Unit& u, int wr, int wc, int fr, int fq) const {
        const int row0 = u.pm * BM + wr * 64 + fr, col = u.pn * BM + wc * 32 + 8 * fq;
#pragma unroll
        for (int ai = 0; ai < 2; ++ai)
#pragma unroll
            for (int m = 0; m < 4; ++m) { const size_t row = (size_t)(row0 + ai * HALF + m * 16);
#pragma unroll
                for (int bj = 0; bj < 2; ++bj) { const int c = col + bj * HALF;
                    const u32x4 gw = *(const PG8_GAS u32x4*)(SG + row * 2048 + gcol0 + c);
                    f32x4 v0 = acc[ai][bj][m][0], v1 = acc[ai][bj][m][1];
                    v0 = v0 * (f32x4){bf_lo(gw.x), bf_hi(gw.x), bf_lo(gw.y), bf_hi(gw.y)}; v1 = v1 * (f32x4){bf_lo(gw.z), bf_hi(gw.z), bf_lo(gw.w), bf_hi(gw.w)};
                    PG8_GAS u32x4* dst = (PG8_GAS u32x4*)(Mg + row * 1024 + c);
                    if (MODE == 1) { const u32x4 ow = *dst; v0 = v0 + (f32x4){bf_lo(ow.x), bf_hi(ow.x), bf_lo(ow.y), bf_hi(ow.y)}; v1 = v1 + (f32x4){bf_lo(ow.z), bf_hi(ow.z), bf_lo(ow.w), bf_hi(ow.w)}; }
                    u32x4 w; w.x = cvt_pk_bf16(v0[0], v0[1]); w.y = cvt_pk_bf16(v0[2], v0[3]); w.z = cvt_pk_bf16(v1[0], v1[1]); w.w = cvt_pk_bf16(v1[2], v1[3]);
                    *dst = w; } }
    }
};
struct EpiRes {
    static constexpr bool PERM = false, AFTER_DRAIN = false;
    const PG8_GAS float* base; PG8_GAS float* out;
    __device__ __forceinline__ void operator()(const f32x4 (&acc)[2][2][4][2], const Unit& u, int wr, int wc, int fr, int fq) const {
        const int row0 = u.pm * BM + wr * 64 + fr, col = u.pn * BM + wc * 32 + 4 * fq;
#pragma unroll
        for (int ai = 0; ai < 2; ++ai)
#pragma unroll
            for (int m = 0; m < 4; ++m) { const size_t off = (size_t)(row0 + ai * HALF + m * 16) * 1024 + col;
#pragma unroll
                for (int bj = 0; bj < 2; ++bj)
#pragma unroll
                    for (int n = 0; n < 2; ++n) { const f32x4 b = *(const PG8_GAS f32x4*)(base + off + bj * HALF + n * 16); *(PG8_GAS f32x4*)(out + off + bj * HALF + n * 16) = b + acc[ai][bj][m][n]; } }
    }
};
struct EpiStore {
    static constexpr bool PERM = false, AFTER_DRAIN = false;
    PG8_GAS bf16_t* O; int ldc;
    __device__ __forceinline__ void operator()(const f32x4 (&acc)[2][2][4][2], const Unit& u, int wr, int wc, int fr, int fq) const {
        const int row0 = u.pm * BM + wr * 64 + fr, col = u.pn * BM + wc * 32 + 8 * fq;
#pragma unroll
        for (int ai = 0; ai < 2; ++ai)
#pragma unroll
            for (int m = 0; m < 4; ++m) { PG8_GAS bf16_t* rowp = O + (size_t)(row0 + ai * HALF + m * 16) * ldc + col;
#pragma unroll
                for (int bj = 0; bj < 2; ++bj) { const f32x4 v0 = acc[ai][bj][m][0], v1 = acc[ai][bj][m][1];
                    u32x4 w; w.x = cvt_pk_bf16(v0[0], v0[1]); w.y = cvt_pk_bf16(v0[2], v0[3]); w.z = cvt_pk_bf16(v1[0], v1[1]); w.w = cvt_pk_bf16(v1[2], v1[3]);
                    *(PG8_GAS u32x4*)(rowp + bj * HALF) = w; } }
    }
};

template <class Epi, class Sched, bool ALIGN_EPI = false, bool SP2 = false>
__device__ __forceinline__ void gemm_phase(PG8_LAS unsigned char* lds, const Gemm g, const Sched& S, const Epi& E) {
    int tid_ = threadIdx.x; asm volatile("" : "+v"(tid_));
    const int tid = tid_, wid = __builtin_amdgcn_readfirstlane(tid >> 6), lane = tid & 63, wr = wid >> 2, wc = wid & 3, fr = lane & 15, fq = lane >> 4;
    const int K = g.K, nt = K / BK;
    unsigned voffA[2], voffB[2];
#pragma unroll
    for (int i = 0; i < 2; ++i) { int R, C; stage_rc(tid * 16 + i * 8192, R, C); const int Rb = Epi::PERM ? ((R & ~31) + perm32(R & 31)) : R;
        voffA[i] = (unsigned)(R * K + C) * 2u; voffB[i] = (unsigned)(Rb * K + C) * 2u; }
    const size_t kstep = (size_t)(BK * 2);
    const size_t hstep = (size_t)HALF * K * 2;
    const size_t tstep = 2 * hstep;
    const unsigned ldsw = (unsigned)wid * 1024u;
    const int aoff = lds_byte(wr * 64 + fr, fq * 8), boff = lds_byte(wc * 32 + fr, fq * 8);
#define PG8_SA(b, h) (((b) * 2 + (h)) * HTB)
#define PG8_SB(b, h) ((4 + (b) * 2 + (h)) * HTB)
#define PG8_STAGE(bufoff, gbase, voff) do { _Pragma("unroll") for (int _i = 0; _i < 2; ++_i) \
        __builtin_amdgcn_global_load_lds((const unsigned*)((const char*)(gbase) + (voff)[_i]), (PG8_LAS unsigned*)(lds + (bufoff) + ldsw + _i * 8192), 16, 0, 0); } while (0)
#define PG8_LDA(dst, b, h) do { _Pragma("unroll") for (int m = 0; m < 4; ++m) _Pragma("unroll") for (int k = 0; k < 2; ++k) dst[m][k] = *(const PG8_LAS bf16x8*)(lds + PG8_SA(b, h) + aoff + m * 2048 + k * 1024); } while (0)
#define PG8_LDB(dst, b, h) do { _Pragma("unroll") for (int n = 0; n < 2; ++n) _Pragma("unroll") for (int k = 0; k < 2; ++k) dst[n][k] = *(const PG8_LAS bf16x8*)(lds + PG8_SB(b, h) + boff + n * 2048 + k * 1024); } while (0)
#define PG8_MMA(ai, bj, At, Bt) do { __builtin_amdgcn_s_setprio(1); _Pragma("unroll") for (int m = 0; m < 4; ++m) _Pragma("unroll") for (int n = 0; n < 2; ++n) _Pragma("unroll") for (int k = 0; k < 2; ++k) \
        acc[ai][bj][m][n] = __builtin_amdgcn_mfma_f32_16x16x32_bf16(Bt[n][k], At[m][k], acc[ai][bj][m][n], 0, 0, 0); __builtin_amdgcn_s_setprio(0); } while (0)
#define PG8_WAIT_V(n) asm volatile("s_waitcnt vmcnt(" #n ")" ::: "memory")
#define PG8_WAIT_L(n) asm volatile("s_waitcnt lgkmcnt(" #n ")" ::: "memory")
#define PG8_BAR __builtin_amdgcn_s_barrier()
#define PG8_SCHED __builtin_amdgcn_sched_barrier(0)
    Unit cur, nxt; int ui = 0;
    if (!S.next(0, cur)) return;
    f32x4 acc[2][2][4][2];
#pragma unroll
    for (int a = 0; a < 2; ++a)
#pragma unroll
        for (int b = 0; b < 2; ++b)
#pragma unroll
            for (int m = 0; m < 4; ++m)
#pragma unroll
                for (int n = 0; n < 2; ++n) acc[a][b][m][n] = (f32x4){0.f, 0.f, 0.f, 0.f};
    bf16x8 At[4][2], B0[2][2], B1[2][2];
    const char* cA = (const char*)g.A + (size_t)cur.pm * tstep; const char* cB = (const char*)g.Bt + (size_t)cur.pn * tstep;
    S.a_ready(cur);
    if constexpr (SP2) {
        PG8_STAGE(PG8_SB(0, 0), cB, voffB); PG8_STAGE(PG8_SB(0, 1), cB + hstep, voffB); PG8_STAGE(PG8_SA(0, 0), cA, voffA); PG8_STAGE(PG8_SA(0, 1), cA + hstep, voffA);
        if (wr == 1) PG8_BAR;
        PG8_WAIT_V(2); PG8_BAR;
        PG8_STAGE(PG8_SB(1, 0), cB + kstep, voffB); PG8_STAGE(PG8_SA(1, 0), cA + kstep, voffA); PG8_STAGE(PG8_SB(1, 1), cB + hstep + kstep, voffB);
        PG8_WAIT_V(6); PG8_BAR;
    } else {
        PG8_STAGE(PG8_SB(0, 0), cB, voffB); PG8_STAGE(PG8_SA(0, 0), cA, voffA); PG8_STAGE(PG8_SB(0, 1), cB + hstep, voffB); PG8_STAGE(PG8_SA(0, 1), cA + hstep, voffA);
        if (wr == 1) PG8_BAR;
        PG8_WAIT_V(4); PG8_BAR;
        PG8_STAGE(PG8_SB(1, 0), cB + kstep, voffB); PG8_STAGE(PG8_SA(1, 0), cA + kstep, voffA); PG8_STAGE(PG8_SB(1, 1), cB + hstep + kstep, voffB);
        PG8_WAIT_V(6); PG8_BAR;
    }
    for (;;) {
        const bool has_next = S.next(ui + 1, nxt);
        const char* nA = has_next ? (const char*)g.A + (size_t)nxt.pm * tstep : cA; const char* nB = has_next ? (const char*)g.Bt + (size_t)nxt.pn * tstep : cB;
        for (int t = 0; t < nt; t += 2) {
            const bool last = (t == nt - 2);
            const char* a1 = cA + (size_t)(t + 1) * kstep;
            const char* a2 = last ? nA : cA + (size_t)(t + 2) * kstep; const char* b2 = last ? nB : cB + (size_t)(t + 2) * kstep;
            const char* a3 = a2 + kstep; const char* b3 = b2 + kstep;
            if (last && has_next) S.a_ready(nxt);
            if constexpr (SP2) {
            PG8_LDB(B0, 0, 0); PG8_LDB(B1, 0, 1); PG8_SCHED; PG8_LDA(At, 0, 0); PG8_STAGE(PG8_SA(1, 1), a1 + hstep, voffA);
            PG8_WAIT_V(8); PG8_WAIT_L(0); PG8_BAR; PG8_MMA(0, 0, At, B0); PG8_MMA(0, 1, At, B1); PG8_BAR; PG8_SCHED;
            PG8_LDA(At, 0, 1); PG8_STAGE(PG8_SB(0, 0), b2, voffB); PG8_STAGE(PG8_SB(0, 1), b2 + hstep, voffB); PG8_STAGE(PG8_SA(0, 0), a2, voffA);
            PG8_WAIT_V(8); PG8_WAIT_L(0); PG8_BAR; PG8_MMA(1, 0, At, B0); PG8_MMA(1, 1, At, B1); PG8_BAR; PG8_SCHED;
            PG8_LDB(B0, 1, 0); PG8_LDB(B1, 1, 1); PG8_SCHED; PG8_LDA(At, 1, 0); PG8_STAGE(PG8_SA(0, 1), a2 + hstep, voffA);
            PG8_WAIT_V(8); PG8_WAIT_L(0); PG8_BAR; PG8_MMA(0, 0, At, B0); PG8_MMA(0, 1, At, B1); PG8_BAR; PG8_SCHED;
            PG8_LDA(At, 1, 1); PG8_STAGE(PG8_SB(1, 0), b3, voffB); PG8_STAGE(PG8_SB(1, 1), b3 + hstep, voffB); PG8_STAGE(PG8_SA(1, 0), a3, voffA);
            PG8_WAIT_V(8); PG8_WAIT_L(0); PG8_BAR; PG8_MMA(1, 0, At, B0); PG8_MMA(1, 1, At, B1); PG8_BAR; PG8_SCHED;
            } else {
            PG8_LDB(B0, 0, 0); PG8_SCHED; PG8_LDA(At, 0, 0); PG8_STAGE(PG8_SA(1, 1), a1 + hstep, voffA);
            PG8_WAIT_L(8); PG8_BAR; PG8_WAIT_L(0); PG8_MMA(0, 0, At, B0); PG8_BAR; PG8_SCHED;
            PG8_LDB(B1, 0, 1); PG8_STAGE(PG8_SB(0, 0), b2, voffB);
            PG8_BAR; PG8_WAIT_L(0); PG8_MMA(0, 1, At, B1); PG8_BAR;
            PG8_LDA(At, 0, 1); PG8_STAGE(PG8_SA(0, 0), a2, voffA);
            PG8_BAR; PG8_WAIT_L(0); PG8_MMA(1, 0, At, B0); PG8_BAR; PG8_SCHED;
            PG8_STAGE(PG8_SB(0, 1), b2 + hstep, voffB);
            PG8_WAIT_V(6); PG8_BAR; PG8_MMA(1, 1, At, B1); PG8_BAR;
            PG8_LDB(B0, 1, 0); PG8_SCHED; PG8_LDA(At, 1, 0); PG8_STAGE(PG8_SA(0, 1), a2 + hstep, voffA);
            PG8_WAIT_L(8); PG8_BAR; PG8_WAIT_L(0); PG8_MMA(0, 0, At, B0); PG8_BAR; PG8_SCHED;
            PG8_LDB(B1, 1, 1); PG8_STAGE(PG8_SB(1, 0), b3, voffB);
            PG8_BAR; PG8_WAIT_L(0); PG8_MMA(0, 1, At, B1); PG8_BAR;
            PG8_LDA(At, 1, 1); PG8_STAGE(PG8_SA(1, 0), a3, voffA);
            PG8_BAR; PG8_WAIT_L(0); PG8_MMA(1, 0, At, B0); PG8_BAR; PG8_SCHED;
            PG8_STAGE(PG8_SB(1, 1), b3 + hstep, voffB);
            PG8_WAIT_V(6); PG8_BAR; PG8_MMA(1, 1, At, B1); PG8_BAR;
            }
        }
        if constexpr (ALIGN_EPI) { if (wr == 0) PG8_BAR; }
        if constexpr (!Epi::AFTER_DRAIN) { E(acc, cur, wr, wc, fr, fq); S.done(cur); }
        if (!has_next) break;
#pragma unroll
        for (int a = 0; a < 2; ++a)
#pragma unroll
            for (int b = 0; b < 2; ++b)
#pragma unroll
                for (int m = 0; m < 4; ++m)
#pragma unroll
                    for (int n = 0; n < 2; ++n) acc[a][b][m][n] = (f32x4){0.f, 0.f, 0.f, 0.f};
        cur = nxt; cA = nA; cB = nB; ++ui;
        if constexpr (ALIGN_EPI) { if (wr == 1) PG8_BAR; }
    }
    PG8_WAIT_V(0);
    if constexpr (!ALIGN_EPI) { if (wr == 0) PG8_BAR; }
    PG8_BAR;
    if constexpr (Epi::AFTER_DRAIN) { E.fused(acc, cur, wr, wc, fr, fq, lds, wid, lane); S.done(cur); }
#undef PG8_SA
#undef PG8_SB
#undef PG8_STAGE
#undef PG8_LDA
#undef PG8_LDB
#undef PG8_MMA
#undef PG8_WAIT_V
#undef PG8_WAIT_L
#undef PG8_BAR
#undef PG8_SCHED
}
}
#include <hip/hip_bf16.h>
#include <cmath>
namespace attn_body {
using bf16=__hip_bfloat16;
using bf16x8=__attribute__((ext_vector_type(8)))short;
using s16x4=__attribute__((ext_vector_type(4)))short;
using f32x16=__attribute__((ext_vector_type(16)))float;
using u32x4=__attribute__((ext_vector_type(4)))unsigned;
constexpr int D=64;
constexpr int NW=8,QBLK=32,QB=QBLK*NW,KVBLK=64;
__device__ __forceinline__ int crow(int r,int hi){return (r&3)+8*(r>>2)+4*hi;}
#define SBAR() __builtin_amdgcn_sched_barrier(0)
constexpr int NSLOT=3, SLOTB=8192;
constexpr int LDS_K=0, LDS_V=NSLOT*SLOTB, LDS_WS=2*NSLOT*SLOTB, LDS_OST=LDS_WS+NW*64*4, LDS_BYTES=LDS_OST+NW*4096;
constexpr float C2=0.125f*1.4426950408889634f;
__device__ __forceinline__ void glds16(const void*gsrc,unsigned lds_dst){unsigned keep;
  asm volatile("s_mov_b32 %0, m0\n\ts_mov_b32 m0, %2\n\ts_nop 0\n\tglobal_load_lds_dwordx4 %1, off\n\ts_mov_b32 m0, %0":"=&s"(keep):"v"(gsrc),"s"(lds_dst):"memory");}
__device__ __forceinline__ float max3f(float a,float b,float c){float r;asm("v_max3_f32 %0, %1, %2, %3":"=v"(r):"v"(a),"v"(b),"v"(c));return r;}
__device__ __forceinline__ float max2f(float a,float b){float r;asm("v_max_f32_e32 %0, %1, %2":"=v"(r):"v"(a),"v"(b));return r;}
__device__ __forceinline__ float fadd_s(float a,float b){float r;asm("v_add_f32_e32 %0, %1, %2":"=v"(r):"v"(a),"v"(b));return r;}
__device__ __forceinline__ float fsub_s(float a,float b){float r;asm("v_sub_f32_e32 %0, %1, %2":"=v"(r):"v"(a),"v"(b));return r;}
typedef float f32x2_t __attribute__((ext_vector_type(2))); typedef __bf16 bf16x2_t __attribute__((ext_vector_type(2)));
__device__ __forceinline__ unsigned cvtpk_s(float lo,float hi){f32x2_t v={lo,hi};bf16x2_t b=__builtin_convertvector(v,bf16x2_t);return __builtin_bit_cast(unsigned,b);}
#define WAIT_BAR(N) asm volatile("s_waitcnt vmcnt(" #N ") lgkmcnt(0)\n\ts_barrier":::"memory")

__device__ __forceinline__ void qkt(f32x16&p0,f32x16&p1,const char*Kslot,const bf16x8*qr,const f32x16&negm,int r32,int hi){
  const char*kb=Kslot+hi*1024+r32*16;
  #pragma unroll
  for(int d0=0;d0<4;++d0){
    const bf16x8 b0=*reinterpret_cast<const bf16x8*>(kb+d0*2048);
    const bf16x8 b1=*reinterpret_cast<const bf16x8*>(kb+d0*2048+512);
    if(d0==0){p0=__builtin_amdgcn_mfma_f32_32x32x16_bf16(b0,qr[0],negm,0,0,0);p1=__builtin_amdgcn_mfma_f32_32x32x16_bf16(b1,qr[0],negm,0,0,0);}
    else{p0=__builtin_amdgcn_mfma_f32_32x32x16_bf16(b0,qr[d0],p0,0,0,0);p1=__builtin_amdgcn_mfma_f32_32x32x16_bf16(b1,qr[d0],p1,0,0,0);}}
}
typedef __attribute__((address_space(3))) const char* lds_cptr;
typedef short v4i16_t __attribute__((ext_vector_type(4)));
__device__ __forceinline__ void kload8(bf16x8*kf,lds_cptr kp){
  kf[0]=*(const __attribute__((address_space(3))) bf16x8*)(kp);      kf[1]=*(const __attribute__((address_space(3))) bf16x8*)(kp+512);
  kf[2]=*(const __attribute__((address_space(3))) bf16x8*)(kp+2048); kf[3]=*(const __attribute__((address_space(3))) bf16x8*)(kp+2560);
  kf[4]=*(const __attribute__((address_space(3))) bf16x8*)(kp+4096); kf[5]=*(const __attribute__((address_space(3))) bf16x8*)(kp+4608);
  kf[6]=*(const __attribute__((address_space(3))) bf16x8*)(kp+6144); kf[7]=*(const __attribute__((address_space(3))) bf16x8*)(kp+6656);
}
__device__ __forceinline__ void kload2(bf16x8*kf,lds_cptr kp,int j){ kf[2*j]=*(const __attribute__((address_space(3))) bf16x8*)(kp+j*2048); kf[2*j+1]=*(const __attribute__((address_space(3))) bf16x8*)(kp+j*2048+512); }
__device__ __forceinline__ s16x4 vtr(lds_cptr p){ return __builtin_bit_cast(s16x4,__builtin_amdgcn_ds_read_tr16_b64_v4i16((__attribute__((address_space(3))) v4i16_t*)p)); }
__device__ __forceinline__ float rowmax(const f32x16&p0,const f32x16&p1){
  float a=max3f(p0[0],p0[1],p1[0]),b=max3f(p0[2],p0[3],p1[1]);a=max3f(a,p1[2],p1[3]);
  #pragma unroll
  for(int r=4;r<16;r+=4){a=max3f(a,p0[r],p0[r+1]);b=max3f(b,p0[r+2],p0[r+3]);a=max3f(a,p1[r],p1[r+1]);b=max3f(b,p1[r+2],p1[r+3]);}
  const float m=max2f(a,b);
  auto rr=__builtin_amdgcn_permlane32_swap(__float_as_uint(m),__float_as_uint(m),false,false);
  return max2f(__uint_as_float(rr[0]),__uint_as_float(rr[1]));
}
__device__ __forceinline__ void pv(f32x16*o,int vb,bf16x8 pa0,bf16x8 pa1,bf16x8 pa2,bf16x8 pa3){
  #pragma unroll
  for(int d0=0;d0<2;++d0){s16x4 lo[4],hi[4];
    #pragma unroll
    for(int ks=0;ks<4;++ks){
      asm volatile("ds_read_b64_tr_b16 %0,%1 offset:%c2":"=&v"(lo[ks]):"v"(vb),"i"(d0*4096+ks*1024):"memory");
      asm volatile("ds_read_b64_tr_b16 %0,%1 offset:%c2":"=&v"(hi[ks]):"v"(vb),"i"(d0*4096+ks*1024+512):"memory");}
    asm volatile("s_waitcnt lgkmcnt(0)":::"memory");SBAR();
    #define PK(k) (bf16x8){lo[k][0],lo[k][1],lo[k][2],lo[k][3],hi[k][0],hi[k][1],hi[k][2],hi[k][3]}
    o[d0]=__builtin_amdgcn_mfma_f32_32x32x16_bf16(pa0,PK(0),o[d0],0,0,0);
    o[d0]=__builtin_amdgcn_mfma_f32_32x32x16_bf16(pa1,PK(1),o[d0],0,0,0);
    o[d0]=__builtin_amdgcn_mfma_f32_32x32x16_bf16(pa2,PK(2),o[d0],0,0,0);
    o[d0]=__builtin_amdgcn_mfma_f32_32x32x16_bf16(pa3,PK(3),o[d0],0,0,0);
    #undef PK
  }
}

#ifndef ATTN_STORE16
#define ATTN_STORE16(p,v) (*(u32x4*)(p)=(v))
#endif
constexpr int LDS_NATAB=86016;
__device__ __forceinline__ void namask(f32x16&p0,f32x16&p1,int kr,int rs,lds_cptr shm3,int toff,int cb){
  const float NEG=-INFINITY;
  if(kr>=rs&&kr<rs+8){
    const __attribute__((address_space(3))) float*tr=(const __attribute__((address_space(3))) float*)(shm3+LDS_NATAB)+(toff+kr*128);
    #pragma unroll
    for(int r=0;r<16;++r){const int c0=(r&3)+8*(r>>2);
      const float b0=tr[c0],b1=tr[c0+32];
      p0[r]=((unsigned)(c0+cb)<16u)?p0[r]+b0:NEG; p1[r]=((unsigned)(c0+32+cb)<16u)?p1[r]+b1:NEG;}
  }else{
    #pragma unroll
    for(int r=0;r<16;++r){p0[r]=NEG;p1[r]=NEG;}
  }
}
template<int MODE,int THRL,int QP,int KP> __device__ __forceinline__ void attn_unit(const bf16*Qu,const bf16*__restrict__ Kt,const bf16*__restrict__ Vt,bf16*Ou,const int NT,const int rq0,const int krow0,char*shm){
  int tid_=threadIdx.x; asm volatile("":"+v"(tid_)); const int tid=tid_,lane=tid&63,r32=lane&31,hi=lane>>5; const int wid=__builtin_amdgcn_readfirstlane(tid>>6);
  const bf16*Qw=Qu+(long)(wid*QBLK)*QP;
  const bf16*Kh=Kt,*Vh=Vt;
  const unsigned lds0=(unsigned)(uintptr_t)shm;
  float*wsf=(float*)(shm+LDS_WS)+wid*64;
  const bf16*ksrc=Kh+(long)lane*KP+wid*8;
  const bf16*vsrc=Vh+(long)(16*(wid&3)+(lane>>2))*KP+(wid>>2)*32+(lane&3)*8;
  const unsigned kdst=lds0+LDS_K+wid*1024, vdst=lds0+LDS_V+wid*1024;
  #define DMA_K(t,slot) glds16(ksrc+(long)(t)*KVBLK*KP,(unsigned)__builtin_amdgcn_readfirstlane(kdst+(slot)))
  #define DMA_V(t,slot) glds16(vsrc+(long)(t)*KVBLK*KP,(unsigned)__builtin_amdgcn_readfirstlane(vdst+(slot)))
  const int vb0=(int)(lds0+LDS_V)+((lane>>4)&1)*32+(lane&3)*8+(4*hi+((lane&15)>>2))*64;
  const char*Kbase=shm+LDS_K; bf16x8 kf[8];
  const lds_cptr shm3=(lds_cptr)shm; const lds_cptr kp0=shm3+LDS_K+hi*1024+r32*16; const lds_cptr vp0=shm3+LDS_V+((lane>>4)&1)*32+(lane&3)*8+(4*hi+((lane&15)>>2))*64;
  DMA_K(0,0);DMA_V(0,0);DMA_K(1,SLOTB);
  bf16x8 qr[4];
  #pragma unroll
  for(int d0=0;d0<4;++d0)qr[d0]=*reinterpret_cast<const bf16x8*>(&Qw[(long)r32*QP+d0*16+hi*8]);
  float mhat=0.f,l_reg=0.f;f32x16 o[2];o[0]=f32x16{};o[1]=f32x16{};f32x16 negm=f32x16{};asm volatile("":"+v"(negm));
  const int na_rq=rq0+(wid>>1), na_cq=32*(wid&1)+r32; const int na_rs=na_rq<4?0:(na_rq>28?24:na_rq-4); const int na_cs=na_cq<8?0:(na_cq>56?48:na_cq-8);
  const int na_toff=(7-na_rq)*128+63-na_cq+4*hi, na_cb=4*hi-na_cs;
  #define CMASK(P0,P1,t) do{ if constexpr(MODE==1) namask(P0,P1,krow0+(t),na_rs,shm3,na_toff,na_cb); }while(0)
  bool resc=false;
  #define START(P0,P1) do{ const float rm=rowmax(P0,P1); resc=false; \
    { const float dl=(MODE==1)?__builtin_fmaxf(rm,-16.f):rm; mhat=fadd_s(mhat,dl); \
      _Pragma("unroll") for(int r=0;r<16;++r){P0[r]=fsub_s(P0[r],dl);P1[r]=fsub_s(P1[r],dl);} \
      _Pragma("unroll") for(int r=0;r<16;++r)negm[r]=-mhat; asm volatile("":"+v"(negm)); } \
    _Pragma("unroll") for(int r=0;r<16;++r)P0[r]=__builtin_amdgcn_exp2f(P0[r]); }while(0)
  #define RESC() do{ if(resc){ asm volatile("s_waitcnt lgkmcnt(0)":::"memory"); \
      _Pragma("unroll") for(int d_=0;d_<2;++d_) _Pragma("unroll") for(int r=0;r<16;++r)o[d_][r]*=wsf[crow(r,hi)]; } }while(0)
  f32x16 pA0,pA1,pB0,pB1;
  int sl_prev=0,sl_cur=0,sl_next=SLOTB;
  #define ROT() do{sl_prev=sl_cur;sl_cur=sl_next;sl_next=(sl_next==(NSLOT-1)*SLOTB)?0:sl_next+SLOTB;}while(0)
  DMA_K(2,2*SLOTB);
  WAIT_BAR(3);
  qkt(pA0,pA1,Kbase,qr,negm,r32,hi);asm volatile("s_nop 15\n\ts_nop 7":"+v"(pA0),"+v"(pA1));CMASK(pA0,pA1,0);
  START(pA0,pA1);
  _Pragma("unroll") for(int r=0;r<16;++r)pA1[r]=__builtin_amdgcn_exp2f(pA1[r]);
  WAIT_BAR(0);
  DMA_K(3,0);DMA_V(1,SLOTB);
  ROT();
  kload8(kf,kp0+sl_cur);
  WAIT_BAR(2);
  s16x4 vlo[8],vhi[8]; u32x4 pw0,pw1,pw2,pw3;
  #define PKW(P,B) cvtpk_s(P[B],P[B+1])
  #define PAF(k) __builtin_bit_cast(bf16x8,pw##k)
  #define VFR(i) (bf16x8){vlo[i][0],vlo[i][1],vlo[i][2],vlo[i][3],vhi[i][0],vhi[i][1],vhi[i][2],vhi[i][3]}
  #define PIN(x) asm volatile("":"+v"(x))
  #define MX3(a,b,c) __builtin_fmaxf(__builtin_fmaxf((a),(b)),(c))
  #define GAPA(MF,A0,A1,A2,A3,W0,W1,PW) do{ MF; sacc+=A0; sacc+=A1; sacc+=A2; sacc+=A3; PIN(sacc); W0; W1; PIN(PW); SBAR(); }while(0)
  #define EX(v) __builtin_amdgcn_exp2f(v)
  #define GAPB(MF,X,B) do{ MF; X[B]=EX(X[B]); X[B+1]=EX(X[B+1]); X[B+2]=EX(X[B+2]); X[B+3]=EX(X[B+3]); PIN(X); SBAR(); }while(0)
  #define VRD(i) do{ vlo[i]=vtr(vp_+(((i)>>2)*4096+((i)&3)*1024)); vhi[i]=vtr(vp_+(((i)>>2)*4096+((i)&3)*1024+512)); }while(0)
  #define KRD(G,j) do{ if(G){ kload2(kf,kp0+sl_next,j); SBAR(); } }while(0)
  #define STEP(C0,C1,P0,P1,t,GK,GV,GL) do{ SBAR(); \
    const lds_cptr vp_=vp0+sl_prev; \
    VRD(0); SBAR(); float sacc=(P0[0]+P0[1]); \
    GAPA(C0=__builtin_amdgcn_mfma_f32_32x32x16_bf16(kf[0],qr[0],negm,0,0,0), P0[2],P0[3],P0[4],P0[5],     pw0[0]=PKW(P0,0), pw0[1]=PKW(P0,2), pw0); \
    VRD(4); SBAR(); GAPA(C1=__builtin_amdgcn_mfma_f32_32x32x16_bf16(kf[1],qr[0],negm,0,0,0), P0[6],P0[7],P0[8],P0[9],     pw0[2]=PKW(P0,4), pw0[3]=PKW(P0,6), pw0); \
    VRD(1); SBAR(); GAPA(C0=__builtin_amdgcn_mfma_f32_32x32x16_bf16(kf[2],qr[1],C0,0,0,0),   P0[10],P0[11],P0[12],P0[13], pw1[0]=PKW(P0,8), pw1[1]=PKW(P0,10), pw1); \
    VRD(5); SBAR(); GAPA(C1=__builtin_amdgcn_mfma_f32_32x32x16_bf16(kf[3],qr[1],C1,0,0,0),   P0[14],P0[15],P1[0],P1[1],   pw1[2]=PKW(P0,12),pw1[3]=PKW(P0,14), pw1); \
    VRD(2); SBAR(); GAPA(C0=__builtin_amdgcn_mfma_f32_32x32x16_bf16(kf[4],qr[2],C0,0,0,0),   P1[2],P1[3],P1[4],P1[5],     pw2[0]=PKW(P1,0), pw2[1]=PKW(P1,2), pw2); \
    VRD(6); SBAR(); GAPA(C1=__builtin_amdgcn_mfma_f32_32x32x16_bf16(kf[5],qr[2],C1,0,0,0),   P1[6],P1[7],P1[8],P1[9],     pw2[2]=PKW(P1,4), pw2[3]=PKW(P1,6), pw2); \
    VRD(3); SBAR(); GAPA(C0=__builtin_amdgcn_mfma_f32_32x32x16_bf16(kf[6],qr[3],C0,0,0,0),   P1[10],P1[11],P1[12],P1[13], pw3[0]=PKW(P1,8), pw3[1]=PKW(P1,10), pw3); \
    VRD(7); SBAR(); GAPA(C1=__builtin_amdgcn_mfma_f32_32x32x16_bf16(kf[7],qr[3],C1,0,0,0),   P1[14],P1[15],0.f,0.f,       pw3[2]=PKW(P1,12),pw3[3]=PKW(P1,14), pw3); \
    l_reg+=sacc; \
    if(GK){DMA_K((t)+3,sl_cur);} if(GV){DMA_V((t)+1,sl_next);} \
    CMASK(C0,C1,t); \
    { float a=MX3(C0[0],C0[1],C1[0]),b=MX3(C0[2],C0[3],C1[1]); a=MX3(a,C1[2],C1[3]); \
      _Pragma("unroll") for(int r=4;r<16;r+=4){a=MX3(a,C0[r],C0[r+1]);b=MX3(b,C0[r+2],C0[r+3]);a=MX3(a,C1[r],C1[r+1]);b=MX3(b,C1[r+2],C1[r+3]);} \
      float rm=__builtin_fmaxf(a,b); { auto rr=__builtin_amdgcn_permlane32_swap(__float_as_uint(rm),__float_as_uint(rm),false,false); rm=__builtin_fmaxf(__uint_as_float(rr[0]),__uint_as_float(rr[1])); } \
      resc=false; \
      if(__builtin_expect(__any(rm>(float)THRL),0)){ const float dl=__builtin_fmaxf(rm,0.f); mhat+=dl; \
        _Pragma("unroll") for(int r=0;r<16;++r){C0[r]-=dl;C1[r]-=dl;} \
        _Pragma("unroll") for(int r=0;r<16;++r)negm[r]=-mhat; asm volatile("":"+v"(negm)); \
        const float f=__builtin_amdgcn_exp2f(-dl); l_reg*=f; if(hi==0)wsf[r32]=f; resc=true; } } \
    SBAR(); \
    GAPB(o[0]=__builtin_amdgcn_mfma_f32_32x32x16_bf16(PAF(0),VFR(0),o[0],0,0,0), C0,0); \
    GAPB(o[1]=__builtin_amdgcn_mfma_f32_32x32x16_bf16(PAF(0),VFR(4),o[1],0,0,0), C0,4); \
    KRD(GL,0); GAPB(o[0]=__builtin_amdgcn_mfma_f32_32x32x16_bf16(PAF(1),VFR(1),o[0],0,0,0), C0,8); \
    KRD(GL,1); GAPB(o[1]=__builtin_amdgcn_mfma_f32_32x32x16_bf16(PAF(1),VFR(5),o[1],0,0,0), C0,12); \
    KRD(GL,2); GAPB(o[0]=__builtin_amdgcn_mfma_f32_32x32x16_bf16(PAF(2),VFR(2),o[0],0,0,0), C1,0); \
    KRD(GL,3); GAPB(o[1]=__builtin_amdgcn_mfma_f32_32x32x16_bf16(PAF(2),VFR(6),o[1],0,0,0), C1,4); \
    GAPB(o[0]=__builtin_amdgcn_mfma_f32_32x32x16_bf16(PAF(3),VFR(3),o[0],0,0,0), C1,8); \
    GAPB(o[1]=__builtin_amdgcn_mfma_f32_32x32x16_bf16(PAF(3),VFR(7),o[1],0,0,0), C1,12); \
    }while(0)
  int t=1;
  for(;t+5<NT;t+=2){
    STEP(pB0,pB1,pA0,pA1,t,true,true,true);     WAIT_BAR(2); RESC(); ROT();
    STEP(pA0,pA1,pB0,pB1,t+1,true,true,true);   WAIT_BAR(2); RESC(); ROT();
  }
  #define ENDW(tt) do{ if((tt)+3<NT){WAIT_BAR(2);} else if((tt)+2<NT){WAIT_BAR(1);} else {WAIT_BAR(0);} }while(0)
  for(;t+1<NT;t+=2){
    STEP(pB0,pB1,pA0,pA1,t,(t+3<NT),(t+1<NT),(t+1<NT));       ENDW(t);   RESC(); ROT();
    STEP(pA0,pA1,pB0,pB1,t+1,(t+4<NT),(t+2<NT),(t+2<NT));     ENDW(t+1); RESC(); ROT();
  }
  STEP(pB0,pB1,pA0,pA1,NT-1,false,false,false); RESC();
  { float sacc=pB0[0]+pB0[1]; _Pragma("unroll") for(int r=2;r<16;++r)sacc+=pB0[r]; _Pragma("unroll") for(int r=0;r<16;++r)sacc+=pB1[r]; l_reg+=sacc;
    pw0=(u32x4){PKW(pB0,0),PKW(pB0,2),PKW(pB0,4),PKW(pB0,6)};pw1=(u32x4){PKW(pB0,8),PKW(pB0,10),PKW(pB0,12),PKW(pB0,14)};pw2=(u32x4){PKW(pB1,0),PKW(pB1,2),PKW(pB1,4),PKW(pB1,6)};pw3=(u32x4){PKW(pB1,8),PKW(pB1,10),PKW(pB1,12),PKW(pB1,14)};
    SBAR(); pv(o,vb0+sl_cur,PAF(0),PAF(1),PAF(2),PAF(3)); }
  #undef PKW
  #undef PAF
  #undef VFR
  #undef PIN
  #undef MX3
  #undef GAPA
  #undef GAPB
  #undef EX
  #undef VRD
  #undef KRD
  #undef STEP
  #undef ENDW
  {auto rr=__builtin_amdgcn_permlane32_swap(__float_as_uint(l_reg),__float_as_uint(l_reg),false,false);l_reg=__uint_as_float(rr[0])+__uint_as_float(rr[1]);}
  if(hi==0)wsf[32+r32]=l_reg;asm volatile("s_waitcnt lgkmcnt(0)":::"memory");
  float rli[16];
  #pragma unroll
  for(int r=0;r<16;++r)rli[r]=__builtin_amdgcn_rcpf(wsf[32+crow(r,hi)]);
  bf16*Ow=Ou+(long)(wid*QBLK)*QP;
  { bf16*stg=(bf16*)(shm+LDS_OST)+wid*2048;
    #pragma unroll
    for(int r=0;r<16;++r){const int orow=crow(r,hi);
      #pragma unroll
      for(int d0=0;d0<2;++d0)stg[orow*64+d0*32+r32]=__float2bfloat16(o[d0][r]*rli[r]);}
    asm volatile("s_waitcnt lgkmcnt(0)":::"memory");
    #pragma unroll
    for(int i=0;i<4;++i){const int row=i*8+(lane>>3),ch=lane&7; const u32x4 v=*(const u32x4*)(stg+row*64+ch*8); ATTN_STORE16(Ow+(long)row*QP+ch*8,v);} }
  asm volatile("s_waitcnt lgkmcnt(0)\n\ts_barrier":::"memory");
  #undef DMA_K
  #undef DMA_V
  #undef CMASK
  #undef START
  #undef RESC
  #undef ROT
}
}

constexpr int NWAVES = 8;
constexpr int RING_OFF = 0, RING_BYTES = 131072;
constexpr int LDSCTL_OFF = RING_BYTES, MISC_OFF = LDSCTL_OFF + 320;
constexpr int LDS_BYTES = 147456;
static_assert(MISC_OFF + 128 <= LDS_BYTES, "LDS map");

#define GAS __attribute__((address_space(1)))
#define LAS __attribute__((address_space(3)))
typedef unsigned short bf16;
typedef unsigned v4u __attribute__((ext_vector_type(4)));
typedef float f32x4 __attribute__((ext_vector_type(4)));
typedef short bf16x8 __attribute__((ext_vector_type(8)));
typedef GAS unsigned gu32;
typedef GAS unsigned long long gu64;
#define RLX_AGENT __ATOMIC_RELAXED, __HIP_MEMORY_SCOPE_AGENT
#define LDS_WAIT() asm volatile("s_waitcnt lgkmcnt(0)" ::: "memory")
#define VM_WAIT() asm volatile("s_waitcnt vmcnt(0)" ::: "memory")
__device__ __forceinline__ unsigned long long rt() { return __builtin_amdgcn_s_memrealtime(); }
__device__ __forceinline__ unsigned f2bf(float f) { unsigned u = __builtin_bit_cast(unsigned, f); return (u + 0x7fffu + ((u >> 16) & 1u)) >> 16; }
__device__ __forceinline__ unsigned pk2(float lo, float hi) { return f2bf(lo) | (f2bf(hi) << 16); }

#define XB_TMO      128
#define XB_XCNT(j)  (256  + 64 * (j))
#define XB_XSUB(j)  (1280 + 64 * (j))
#define XB_XGEN(j)  (2304 + 64 * (j))
#define XB_TOP      3328
#define XB_TOPGEN   3392
#define XCD_BAR_WORDS 3456
#define XB_SPIN_CAP (1u << 18)

__device__ __forceinline__ unsigned xb_ld(unsigned* p)              { return __hip_atomic_load(p, __ATOMIC_RELAXED, __HIP_MEMORY_SCOPE_AGENT); }
__device__ __forceinline__ unsigned xb_add(unsigned* p, unsigned v) { return __hip_atomic_fetch_add(p, v, __ATOMIC_RELAXED, __HIP_MEMORY_SCOPE_AGENT); }
__device__ __forceinline__ unsigned xb_xcc_id() { return (unsigned)__builtin_amdgcn_s_getreg((3 << 11) | 20) & 0xFu; }
#define XB_SPIN(cond, bar) do { unsigned _sp = 0; while (cond) { __builtin_amdgcn_s_sleep(1); \
    if ((++_sp & 255u) == 0u) { if (xb_ld(&(bar)[XB_TMO])) break; if (_sp > XB_SPIN_CAP) { atomicAdd(&(bar)[XB_TMO], 1u); break; } } } } while (0)

struct XcdBarrier {
    unsigned* bar; unsigned x;
    volatile LAS unsigned* st;
};

__device__ __forceinline__ XcdBarrier xcd_barrier_post(unsigned* bar, volatile LAS unsigned* st) {
    XcdBarrier b; b.bar = bar; b.x = xb_xcc_id(); b.st = st;
    if (threadIdx.x == 0) (void)xb_add(&bar[XB_XCNT(b.x)], 1u);
    return b;
}
__device__ __forceinline__ void xcd_barrier_complete(unsigned* bar, unsigned x, unsigned& nloc, unsigned& nx) {
    const unsigned G = gridDim.x * gridDim.y * gridDim.z;
    unsigned sum, cnt, mine, sp = 0u;
    for (;;) {
        sum = 0u; cnt = 0u; mine = 0u;
#pragma unroll
        for (unsigned j = 0; j < 16; ++j) { const unsigned c = xb_ld(&bar[XB_XCNT(j)]); sum += c; cnt += (c > 0u) ? 1u : 0u; mine = (j == x) ? c : mine; }
        if (sum == G) break;
        __builtin_amdgcn_s_sleep(1);
        if ((++sp & 255u) == 0u) { if (xb_ld(&bar[XB_TMO])) break; if (sp > XB_SPIN_CAP) { atomicAdd(&bar[XB_TMO], 1u); break; } }
    }
    nloc = mine > 0u ? mine : 1u; nx = cnt > 0u ? cnt : 1u;
}

__device__ __forceinline__ void xcd_barrier(const XcdBarrier& b) {
    asm volatile("s_waitcnt vmcnt(0)" ::: "memory");
    __syncthreads();
    if (threadIdx.x == 0) {
        unsigned* bar = b.bar;
        __builtin_amdgcn_s_waitcnt(0);
        unsigned nloc = b.st[0], nx = b.st[1];
        if (nloc == 0u) { xcd_barrier_complete(bar, b.x, nloc, nx); b.st[0] = nloc; b.st[1] = nx; }
        const unsigned old = xb_add(&bar[XB_XSUB(b.x)], 1u);
        const unsigned gen = old / nloc;
        if (old + 1u == (gen + 1u) * nloc) {
            __builtin_amdgcn_fence(__ATOMIC_RELEASE, "agent");
            asm volatile("s_waitcnt vmcnt(0)" ::: "memory");
            const unsigned og = xb_add(&bar[XB_TOP], 1u);
            const unsigned tg = og / nx;
            if (og + 1u == (tg + 1u) * nx) xb_add(&bar[XB_TOPGEN], 1u);
            else XB_SPIN(xb_ld(&bar[XB_TOPGEN]) == tg, bar);
            __builtin_amdgcn_fence(__ATOMIC_ACQUIRE, "agent");
            xb_add(&bar[XB_XGEN(b.x)], 1u);
            asm volatile("s_waitcnt vmcnt(0)" ::: "memory");
        } else {
            XB_SPIN(xb_ld(&bar[XB_XGEN(b.x)]) == gen, bar);
            __builtin_amdgcn_fence(__ATOMIC_ACQUIRE, "agent");
            asm volatile("s_waitcnt vmcnt(0)" ::: "memory");
        }
    }
    __syncthreads();
}

typedef unsigned u32x2g __attribute__((ext_vector_type(2)));
struct Frame {
    LAS unsigned char* lds;
    int vcu, G;
};
#define OPAQUE_TID(tid) int tid = threadIdx.x; asm volatile("" : "+v"(tid))
__device__ __forceinline__ float wave_sum(float v) {
#pragma unroll
    for (int o = 1; o < 64; o <<= 1) v += __shfl_xor(v, o);
    return v;
}
__device__ __forceinline__ int phys_row(int mode, int L) {
    if (mode == 0) return L;
    const int tile = L >> 8, lt = L & 255;
    if (mode == 2 && tile >= 6 && tile <= 8) return (tile << 8) + 128 * ((lt >> 5) & 1) + 32 * (lt >> 6) + (lt & 31);
    const int l = L & 31; return (L & ~31) + 16 * ((l >> 2) & 1) + 4 * (l >> 3) + (l & 3);
}
__device__ __forceinline__ void p0_transpose_item(const float* W, int K, int N, bf16* WT, int mode, LAS float* scr, int item, int lane) {
    const int nblk = N / 32, kb = item / nblk, nb = item % nblk, k0 = 64 * kb, n0 = 32 * nb;
#pragma unroll 8
    for (int i = 0; i < 32; ++i) { const int kk = 2 * i + (lane >> 5); scr[kk * 33 + (lane & 31)] = W[(size_t)(k0 + kk) * N + n0 + (lane & 31)]; }
    LDS_WAIT(); asm volatile("" ::: "memory");
    const int c = lane & 7;
#pragma unroll
    for (int j = 0; j < 4; ++j) { const int n = (lane >> 3) + 8 * j; const LAS float* s = scr + (8 * c) * 33 + n;
        v4u o; o.x = pk2(s[0 * 33], s[1 * 33]); o.y = pk2(s[2 * 33], s[3 * 33]); o.z = pk2(s[4 * 33], s[5 * 33]); o.w = pk2(s[6 * 33], s[7 * 33]);
        *(GAS v4u*)(WT + (size_t)phys_row(mode, n0 + n) * K + k0 + 8 * c) = o; }
    LDS_WAIT(); asm volatile("" ::: "memory");
}
__device__ __forceinline__ void rms_row_to_bf16(int lane, const float* xrow, const float* g, bf16* orow) {
    const GAS f32x4* xr = (const GAS f32x4*)xrow + lane; const GAS f32x4* gr = (const GAS f32x4*)g + lane;
    f32x4 v[4]; float s = 0.f;
#pragma unroll
    for (int j = 0; j < 4; ++j) { v[j] = xr[64 * j]; s += (v[j].x * v[j].x + v[j].y * v[j].y) + (v[j].z * v[j].z + v[j].w * v[j].w); }
    const float rstd = 1.f / sqrtf(wave_sum(s) * (1.f / D) + EPS);
    GAS unsigned long long* o8 = (GAS unsigned long long*)orow + lane;
#pragma unroll
    for (int j = 0; j < 4; ++j) { const f32x4 gg = gr[64 * j]; o8[64 * j] = (unsigned long long)pk2(v[j].x * rstd * gg.x, v[j].y * rstd * gg.y) | ((unsigned long long)pk2(v[j].z * rstd * gg.z, v[j].w * rstd * gg.w) << 32); }
}
__device__ __forceinline__ void cvt_stream(const float* src, bf16* dst, size_t n8, size_t gtid, size_t gthreads) {
    for (size_t i = gtid; i < n8; i += gthreads) { const f32x4 a = ((const GAS f32x4*)src)[2 * i], b = ((const GAS f32x4*)src)[2 * i + 1];
        v4u o; o.x = pk2(a.x, a.y); o.y = pk2(a.z, a.w); o.z = pk2(b.x, b.y); o.w = pk2(b.z, b.w); ((GAS v4u*)dst)[i] = o; }
}

__device__ __forceinline__ float wave_max(float v) {
#pragma unroll
    for (int o = 1; o < 64; o <<= 1) v = fmaxf(v, __shfl_xor(v, o));
    return v;
}
__device__ __forceinline__ void row_to_fp8(int lane, const float* src, unsigned char* dst, float* inv) {
    const GAS f32x4* xr = (const GAS f32x4*)src + lane;
    f32x4 v[4]; float am = 0.f;
#pragma unroll
    for (int j = 0; j < 4; ++j) { v[j] = xr[64 * j]; am = fmaxf(am, fmaxf(fmaxf(fabsf(v[j].x), fabsf(v[j].y)), fmaxf(fabsf(v[j].z), fabsf(v[j].w)))); }
    am = wave_max(am);
    const float s = am > 0.f ? 224.f / am : 1.f;
    v4u o; unsigned w[4];
#pragma unroll
    for (int j = 0; j < 4; ++j) { int p = __builtin_amdgcn_cvt_pk_fp8_f32(v[j].x * s, v[j].y * s, 0, false); p = __builtin_amdgcn_cvt_pk_fp8_f32(v[j].z * s, v[j].w * s, p, true); w[j] = (unsigned)p; }
    o.x = w[0]; o.y = w[1]; o.z = w[2]; o.w = w[3];
    ((GAS v4u*)dst)[lane] = o;
    if (lane == 0) *(GAS float*)inv = am > 0.f ? am * (1.f / 224.f) : 1.f;
}
#define CAND_LIST CAND(0,0,0) CAND(1,0,1) CAND(2,0,2) CAND(3,0,3) CAND(4,0,4) CAND(5,0,5) CAND(6,0,6) CAND(7,0,7) CAND(8,0,8) CAND(9,0,9) CAND(10,0,10) CAND(11,0,11) CAND(12,0,12) CAND(13,0,13) CAND(14,0,14) CAND(15,0,15) CAND(16,1,0) CAND(17,1,1) CAND(18,1,2) CAND(19,1,3) CAND(20,1,4) CAND(21,1,5) CAND(22,1,6) CAND(23,1,7) CAND(24,2,0) CAND(25,2,1) CAND(26,2,2) CAND(27,2,3) CAND(28,2,4) CAND(29,3,0) CAND(30,3,1) CAND(31,3,2) CAND(32,3,3) CAND(33,4,0) CAND(34,4,1) CAND(35,4,2) CAND(36,5,0) CAND(37,5,1) CAND(38,6,0) CAND(39,6,1) CAND(40,7,0) CAND(41,7,1) CAND(42,8,0) CAND(43,9,0) CAND(44,10,0) CAND(45,11,0) CAND(46,12,0) CAND(47,13,0) CAND(48,14,0) CAND(49,15,0)
__device__ __forceinline__ int ford(unsigned bits) { const int k = (int)bits; return k ^ ((k >> 31) & 0x7fffffff); }
__device__ __forceinline__ int imx(int a, int b) { return a > b ? a : b; }
__device__ __forceinline__ int imn(int a, int b) { return a < b ? a : b; }
#define CE_D(a, b) do { const int _x = imx(a, b), _n = imn(a, b); a = _x; b = _n; } while (0)
#define CE_A(a, b) do { const int _x = imx(a, b), _n = imn(a, b); a = _n; b = _x; } while (0)
__device__ __forceinline__ void sort16_desc(int (&v)[16]) {
#pragma unroll
    for (int k = 2; k <= 16; k <<= 1)
#pragma unroll
        for (int j = k >> 1; j > 0; j >>= 1)
#pragma unroll
            for (int i = 0; i < 16; ++i) { const int l = i ^ j; if (l > i) { if ((i & k) == 0) CE_D(v[i], v[l]); else CE_A(v[i], v[l]); } }
}
__device__ __forceinline__ void bmerge16(int (&v)[16]) {
#pragma unroll
    for (int j = 8; j > 0; j >>= 1)
#pragma unroll
        for (int i = 0; i < 16; ++i) { const int l = i ^ j; if (l > i) CE_D(v[i], v[l]); }
}
__device__ __forceinline__ void merge_top16(int (&a)[16], const int (&b)[16]) {
#pragma unroll
    for (int i = 0; i < 16; ++i) a[i] = imx(a[i], b[15 - i]);
    bmerge16(a);
}
__device__ __forceinline__ void top16_of_64(const int (&v)[64], int (&out)[16]) {
    int g1[16], g2[16], g3[16];
#pragma unroll
    for (int i = 0; i < 16; ++i) { out[i] = v[i]; g1[i] = v[16 + i]; g2[i] = v[32 + i]; g3[i] = v[48 + i]; }
    sort16_desc(out); sort16_desc(g1); sort16_desc(g2); sort16_desc(g3);
    merge_top16(out, g1); merge_top16(g2, g3); merge_top16(out, g2);
}
typedef float f32x16v __attribute__((ext_vector_type(16)));
constexpr int RT_SCR = 65536;
__device__ __forceinline__ int mkc(int x, int y, unsigned code) {
    const float fs = __builtin_bit_cast(float, (unsigned)ford((unsigned)x)) + __builtin_bit_cast(float, (unsigned)ford((unsigned)y));
    return ford((__builtin_bit_cast(unsigned, fs) & 0xFFFFFF00u) | code); }
__device__ __forceinline__ void route_phase(const Frame& F, unsigned char* ws) {
    const GAS bf16* SUBK = (const GAS bf16*)(ws + WS_SUBK); const GAS bf16* Q2 = (const GAS bf16*)(ws + WS_Q2);
    GAS int* IDX = (GAS int*)(ws + WS_IDX); GAS float* GATE = (GAS float*)(ws + WS_GATE);
    OPAQUE_TID(tid);
    const int lane = tid & 63, r32 = lane & 31, hi = lane >> 5, wid = __builtin_amdgcn_readfirstlane(tid >> 6);
    int cur_h = -1;
    for (int uid = F.vcu; uid < 8 * (T / 256); uid += F.G) {
        const int hh = uid & 7, tok = (uid >> 3) * 256 + wid * 32 + r32;
        if (hh != cur_h) {
            __syncthreads();
#pragma unroll
            for (int it = 0; it < 8; ++it) { const int id = tid + it * 512, p = id >> 11, n = (id >> 4) & 127, ch = id & 15;
                const v4u w = *(const GAS v4u*)(SUBK + ((size_t)((hh * 2 + p) * 128 + n) * 128 + ch * 8));
                *(LAS v4u*)(F.lds + p * 32768 + ch * 2048 + n * 16) = w; }
            __syncthreads(); cur_h = hh;
        }
        int lst[2][16];
#pragma unroll
        for (int p = 0; p < 2; ++p) {
            f32x16v acc[4];
#pragma unroll
            for (int nt = 0; nt < 4; ++nt) { acc[nt] = (f32x16v){}; asm volatile("" : "+v"(acc[nt])); }
            const GAS bf16* qp = Q2 + (size_t)tok * 2048 + hh * 256 + p * 128 + hi * 8;
            bf16x8 bq[8];
#pragma unroll
            for (int ks = 0; ks < 8; ++ks) bq[ks] = *(const GAS bf16x8*)(qp + ks * 16);
#pragma unroll
            for (int ks = 0; ks < 8; ++ks)
#pragma unroll
                for (int nt = 0; nt < 4; ++nt) { const bf16x8 af = *(const LAS bf16x8*)(F.lds + p * 32768 + (2 * ks + hi) * 2048 + (nt * 32 + r32) * 16);
                    acc[nt] = __builtin_amdgcn_mfma_f32_32x32x16_bf16(af, bq[ks], acc[nt], 0, 0, 0); }
            int v[64];
            const unsigned h4 = (unsigned)hi << 2;
#pragma unroll
            for (int nt = 0; nt < 4; ++nt)
#pragma unroll
                for (int r = 0; r < 16; ++r) { const float sc_ = acc[nt][r];
                    v[nt * 16 + r] = ford((__builtin_bit_cast(unsigned, sc_) & 0xFFFFFF80u) | (unsigned)(32 * nt + (r & 3) + 8 * (r >> 2)) | h4); }
            int mine[16], oth[16];
            top16_of_64(v, mine);
#pragma unroll
            for (int i = 0; i < 16; ++i) oth[i] = __shfl_xor(mine[i], 32);
            merge_top16(mine, oth);
#pragma unroll
            for (int i = 0; i < 16; ++i) lst[p][i] = mine[i];
        }
        LAS unsigned* scr = (LAS unsigned*)(F.lds + RT_SCR + wid * 2048 + lane * 32);
#pragma unroll
        for (int p = 0; p < 2; ++p)
#pragma unroll
            for (int q = 0; q < 4; ++q) { unsigned w = 0;
#pragma unroll
                for (int b = 0; b < 4; ++b) w |= ((unsigned)ford((unsigned)lst[p][4 * q + b]) & 127u) << (8 * b);
                scr[p * 4 + q] = w; }
        int cv[64];
#define CAND(c, i, j) cv[c] = mkc(lst[0][i], lst[1][j], (unsigned)((i) * 16 + (j)));
        CAND_LIST
#undef CAND
#pragma unroll
        for (int c = 50; c < 64; ++c) cv[c] = (int)0x80000000;
        int best[16];
        top16_of_64(cv, best);
        asm volatile("s_waitcnt lgkmcnt(0)" ::: "memory");
        const LAS unsigned char* sb = (const LAS unsigned char*)scr;
        int ex[16]; float gt[16]; float gs = 0.f;
        const float b0 = __builtin_bit_cast(float, (unsigned)ford((unsigned)best[0]));
#pragma unroll
        for (int k = 0; k < 16; ++k) { const unsigned kb = (unsigned)ford((unsigned)best[k]), code = kb & 255u;
            ex[k] = (int)sb[code >> 4] * 128 + (int)sb[16 + (code & 15)];
            gt[k] = __builtin_amdgcn_exp2f((__builtin_bit_cast(float, kb) - b0) * 1.4426950408889634f); gs += gt[k]; }
        const float rg = 1.0f / gs;
        if (hi == 0) {
            GAS v4u* ip = (GAS v4u*)(IDX + (size_t)tok * 128 + hh * 16);
#pragma unroll
            for (int q = 0; q < 4; ++q) ip[q] = (v4u){(unsigned)ex[4 * q], (unsigned)ex[4 * q + 1], (unsigned)ex[4 * q + 2], (unsigned)ex[4 * q + 3]};
        } else {
            GAS f32x4* gp = (GAS f32x4*)(GATE + (size_t)tok * 128 + hh * 16);
#pragma unroll
            for (int q = 0; q < 4; ++q) gp[q] = (f32x4){gt[4 * q] * rg, gt[4 * q + 1] * rg, gt[4 * q + 2] * rg, gt[4 * q + 3] * rg};
        }
    }
    __syncthreads();
}
using pg8::bf_lo; using pg8::bf_hi;
typedef float f32x2v __attribute__((ext_vector_type(2)));
__device__ __forceinline__ float dot16_fp8(const v4u w, const f32x2v (&x)[8]) {
    f32x2v a = __builtin_amdgcn_cvt_pk_f32_fp8((int)w.x, false) * x[0];
    a += __builtin_amdgcn_cvt_pk_f32_fp8((int)w.x, true) * x[1];
    f32x2v b = __builtin_amdgcn_cvt_pk_f32_fp8((int)w.y, false) * x[2];
    b += __builtin_amdgcn_cvt_pk_f32_fp8((int)w.y, true) * x[3];
    a += __builtin_amdgcn_cvt_pk_f32_fp8((int)w.z, false) * x[4];
    b += __builtin_amdgcn_cvt_pk_f32_fp8((int)w.z, true) * x[5];
    a += __builtin_amdgcn_cvt_pk_f32_fp8((int)w.w, false) * x[6];
    b += __builtin_amdgcn_cvt_pk_f32_fp8((int)w.w, true) * x[7];
    a += b; return a.x + a.y;
}
__device__ __forceinline__ void axpy16_fp8(f32x2v (&o)[8], const float hv, const v4u w) {
    const f32x2v h2 = {hv, hv};
    o[0] += h2 * __builtin_amdgcn_cvt_pk_f32_fp8((int)w.x, false); o[1] += h2 * __builtin_amdgcn_cvt_pk_f32_fp8((int)w.x, true);
    o[2] += h2 * __builtin_amdgcn_cvt_pk_f32_fp8((int)w.y, false); o[3] += h2 * __builtin_amdgcn_cvt_pk_f32_fp8((int)w.y, true);
    o[4] += h2 * __builtin_amdgcn_cvt_pk_f32_fp8((int)w.z, false); o[5] += h2 * __builtin_amdgcn_cvt_pk_f32_fp8((int)w.z, true);
    o[6] += h2 * __builtin_amdgcn_cvt_pk_f32_fp8((int)w.w, false); o[7] += h2 * __builtin_amdgcn_cvt_pk_f32_fp8((int)w.w, true);
}
__device__ __forceinline__ float reduce16(const float (&d)[16], int lane) {
    float a[8], b[4], c[2];
    const bool b5 = lane & 32, b4 = lane & 16, b3 = lane & 8, b2 = lane & 4;
#pragma unroll
    for (int i = 0; i < 8; ++i) { const float keep = b5 ? d[8 + i] : d[i], send = b5 ? d[i] : d[8 + i]; a[i] = keep + __shfl_xor(send, 32); }
#pragma unroll
    for (int i = 0; i < 4; ++i) { const float keep = b4 ? a[4 + i] : a[i], send = b4 ? a[i] : a[4 + i]; b[i] = keep + __shfl_xor(send, 16); }
#pragma unroll
    for (int i = 0; i < 2; ++i) { const float keep = b3 ? b[2 + i] : b[i], send = b3 ? b[i] : b[2 + i]; c[i] = keep + __shfl_xor(send, 8); }
    float r = (b2 ? c[1] : c[0]) + __shfl_xor(b2 ? c[0] : c[1], 4);
    r += __shfl_xor(r, 2); r += __shfl_xor(r, 1);
    return r;
}
#define SCHED_PIN() __builtin_amdgcn_sched_barrier(0)
#define ISSUE16(w, TAB, ireg) do { _Pragma("unroll") for (int b_ = 0; b_ < 16; ++b_) { const int row_ = __builtin_amdgcn_readlane(ireg, 4 * b_); \
        w[b_] = *(const GAS v4u*)(TAB + (size_t)row_ * D + 16 * lane); } } while (0)
__device__ __forceinline__ void sort_phase(const Frame& F, unsigned char* ws) {
    const GAS int* IDX = (const GAS int*)(ws + WS_IDX); GAS int* SKEY = (GAS int*)(ws + WS_SKEY);
    OPAQUE_TID(tid);
    const int lane = tid & 63; const int gw = F.vcu * NWAVES + __builtin_amdgcn_readfirstlane(tid >> 6), NGW = F.G * NWAVES;
    for (int t = gw; t < T; t += NGW) {
        int e0 = (IDX[(size_t)t * 128 + lane] << 7) | lane, e1 = (IDX[(size_t)t * 128 + 64 + lane] << 7) | (64 + lane);
#pragma unroll
        for (int kk = 2; kk <= 128; kk <<= 1)
#pragma unroll
            for (int j = kk >> 1; j > 0; j >>= 1) {
                const bool up = kk == 128 ? true : ((lane & (kk >> 1)) == 0);
                if (j == 1) { const int mn = e0 < e1 ? e0 : e1, mx = e0 < e1 ? e1 : e0; e0 = up ? mn : mx; e1 = up ? mx : mn; }
                else { const int p0 = __shfl_xor(e0, j >> 1), p1 = __shfl_xor(e1, j >> 1); const bool takemin = ((lane & (j >> 1)) == 0) == up;
                    e0 = takemin ? (e0 < p0 ? e0 : p0) : (e0 < p0 ? p0 : e0); e1 = takemin ? (e1 < p1 ? e1 : p1) : (e1 < p1 ? p1 : e1); } }
        *(GAS u32x2g*)(SKEY + (size_t)t * 128 + 2 * lane) = (u32x2g){(unsigned)e0, (unsigned)e1};
    }
}
__device__ __forceinline__ void act_phase(const Frame& F, unsigned char* ws, unsigned xcc, unsigned* barw) {
    const GAS unsigned char* U = (const GAS unsigned char*)(ws + WS_U); const GAS bf16* XN = (const GAS bf16*)(ws + WS_XN);
    const GAS int* SKEY = (const GAS int*)(ws + WS_SKEY); GAS float* ACT = (GAS float*)(ws + WS_ACT);
    OPAQUE_TID(tid);
    const int lane = tid & 63, wv = __builtin_amdgcn_readfirstlane(tid >> 6);
    LAS int* shr = (LAS int*)(F.lds + 8192);
    if (tid == 0) { int oi = 0, nx = 0, mine = 1;
        for (unsigned j = 0; j < 16; ++j) { const unsigned c = xb_ld(&barw[XB_XCNT(j)]); if (c) { if (j < xcc) ++oi; ++nx; } if (j == xcc) mine = (int)c; }
        shr[0] = oi; shr[1] = nx > 0 ? nx : 1; shr[2] = mine > 0 ? mine : 1; shr[3] = (int)xb_add((unsigned*)(ws + WS_CTL) + 2304 + 64 * xcc, 1u); }
    __syncthreads();
    const int oi = __builtin_amdgcn_readfirstlane(shr[0]), nx = __builtin_amdgcn_readfirstlane(shr[1]), nloc = __builtin_amdgcn_readfirstlane(shr[2]), rank = __builtin_amdgcn_readfirstlane(shr[3]) % nloc;
    const int tb = (int)((long)T * rank / nloc), te = (int)((long)T * (rank + 1) / nloc);
    for (int win = oi; win < 8; win += nx) {
        const int wo = 16 * win + (lane >> 2);
#define TOKC(i) ((tb + wv + (i) * NWAVES) < te ? (tb + wv + (i) * NWAVES) : (te - 1))
#define XLOAD(xp, tok) do { _Pragma("unroll") for (int j_ = 0; j_ < 4; ++j_) xp[j_] = *(const GAS u32x2g*)(XN + (size_t)(tok) * D + 256 * j_ + 4 * lane); } while (0)
#define ACOMP(cur, xp, tok, valid) do { f32x2v x_[8]; _Pragma("unroll") for (int j_ = 0; j_ < 4; ++j_) { x_[2 * j_] = (f32x2v){bf_lo(xp[j_].x), bf_hi(xp[j_].x)}; x_[2 * j_ + 1] = (f32x2v){bf_lo(xp[j_].y), bf_hi(xp[j_].y)}; } \
        float d_[16]; _Pragma("unroll") for (int b_ = 0; b_ < 16; ++b_) d_[b_] = dot16_fp8(cur[b_], x_); const float tot_ = reduce16(d_, lane); \
        if ((valid) && (lane & 3) == 0) ACT[(size_t)(tok) * 128 + wo] = tot_; } while (0)
        if (tb + wv < te) {
            v4u wa[16], wb[16]; u32x2g xa[4], xb[4];
            int ta = TOKC(0), tbn = TOKC(1);
            int ka = SKEY[(size_t)ta * 128 + wo], kbk = SKEY[(size_t)tbn * 128 + wo];
            XLOAD(xa, ta);
            { const int ixv = ka >> 7; ISSUE16(wa, U, ixv); }
            for (int i = 0; tb + wv + i * NWAVES < te; i += 2) {
                const int t2 = TOKC(i + 2), t3 = TOKC(i + 3);
                XLOAD(xb, tbn); { const int ixv = kbk >> 7; ISSUE16(wb, U, ixv); } ka = SKEY[(size_t)t2 * 128 + wo]; SCHED_PIN();
                ACOMP(wa, xa, ta, true); SCHED_PIN();
                const bool v1 = tb + wv + (i + 1) * NWAVES < te;
                XLOAD(xa, t2); { const int ixv = ka >> 7; ISSUE16(wa, U, ixv); } kbk = SKEY[(size_t)t3 * 128 + wo]; SCHED_PIN();
                ACOMP(wb, xb, tbn, v1); SCHED_PIN();
                ta = t2; tbn = t3;
            }
        }
#undef TOKC
#undef XLOAD
#undef ACOMP
    }
    __syncthreads();
}
__device__ __forceinline__ void expert_phase(const Frame& F, unsigned char* ws, const float* gf_, float* out_) {
    const GAS unsigned char* V = (const GAS unsigned char*)(ws + WS_V);
    const GAS float* US = (const GAS float*)(ws + WS_US); const GAS float* VS = (const GAS float*)(ws + WS_VS);
    const GAS int* SKEY = (const GAS int*)(ws + WS_SKEY); const GAS float* GATE = (const GAS float*)(ws + WS_GATE); const GAS float* ACT = (const GAS float*)(ws + WS_ACT);
    const GAS float* gf = (const GAS float*)gf_; GAS float* out = (GAS float*)out_;
    OPAQUE_TID(tid);
    const int lane = tid & 63; const int gw = F.vcu * NWAVES + __builtin_amdgcn_readfirstlane(tid >> 6), NGW = F.G * NWAVES;
    for (int t = gw; t < T; t += NGW) {
        int ix[8]; float hg[8];
#pragma unroll
        for (int be = 0; be < 8; ++be) { const int ky = SKEY[(size_t)t * 128 + 16 * be + (lane >> 2)]; ix[be] = ky >> 7; hg[be] = GATE[(size_t)t * 128 + (ky & 127)]; }
        v4u wa[16], wb[16];
        ISSUE16(wa, V, ix[0]);
        SCHED_PIN();
#pragma unroll
        for (int be = 0; be < 8; ++be) { const float a_ = ACT[(size_t)t * 128 + 16 * be + (lane >> 2)] * US[ix[be]]; hg[be] = 0.5f * a_ * (1.f + erff(a_ * 0.70710678118654752f)) * hg[be] * VS[ix[be]]; }
        f32x2v o[8];
#pragma unroll
        for (int k = 0; k < 8; ++k) o[k] = (f32x2v){0.f, 0.f};
#define OUT_STEP(cur, nxt, be, NEXT_ISSUE) do { NEXT_ISSUE; SCHED_PIN(); _Pragma("unroll") for (int b_ = 0; b_ < 16; ++b_) { \
            const float hv_ = __builtin_bit_cast(float, __builtin_amdgcn_readlane(__builtin_bit_cast(int, hg[be]), 4 * b_)); axpy16_fp8(o, hv_, cur[b_]); } SCHED_PIN(); } while (0)
        OUT_STEP(wa, wb, 0, ISSUE16(wb, V, ix[1])); OUT_STEP(wb, wa, 1, ISSUE16(wa, V, ix[2]));
        OUT_STEP(wa, wb, 2, ISSUE16(wb, V, ix[3])); OUT_STEP(wb, wa, 3, ISSUE16(wa, V, ix[4]));
        OUT_STEP(wa, wb, 4, ISSUE16(wb, V, ix[5])); OUT_STEP(wb, wa, 5, ISSUE16(wa, V, ix[6]));
        OUT_STEP(wa, wb, 6, ISSUE16(wb, V, ix[7])); OUT_STEP(wb, wa, 7, (void)0);
        GAS f32x4* xr = (GAS f32x4*)(out + (size_t)t * D) + lane;
        f32x4 y[4]; float ss = 0.f;
#pragma unroll
        for (int j = 0; j < 4; ++j) { y[j] = xr[64 * j] + (f32x4){o[2 * j].x, o[2 * j].y, o[2 * j + 1].x, o[2 * j + 1].y}; ss += (y[j].x * y[j].x + y[j].y * y[j].y) + (y[j].z * y[j].z + y[j].w * y[j].w); }
        const float r = 1.f / sqrtf(wave_sum(ss) * (1.f / D) + EPS);
        const GAS f32x4* gr = (const GAS f32x4*)gf + lane;
#pragma unroll
        for (int j = 0; j < 4; ++j) xr[64 * j] = y[j] * r * gr[64 * j];
#ifdef PROBE_PT
        if (t == 0 && lane == 0) { const unsigned long long dt = ((const GAS unsigned long long*)(ws + WS_CTL))[1025]; out[0] += (float)dt * (1.0f / PROBE_DIV); }
#endif
    }
}
struct Args { const float* in[15]; float* out; unsigned char* ws; };
#define KARGS(ap) const __attribute__((address_space(4))) Args* ap; { auto kp_ = __builtin_amdgcn_kernarg_segment_ptr(); asm volatile("" : "+s"(kp_)); ap = (const __attribute__((address_space(4))) Args*)kp_; }
#define PGG(T_, p) ((PG8_GAS T_*)(p))
__global__ void __launch_bounds__(NWAVES * 64, 2) mk_fwd(Args args) {
    extern __shared__ __attribute__((aligned(16))) unsigned char lds[];
    Frame F;
    F.lds = (LAS unsigned char*)lds;
    F.G = gridDim.x; { const int bx = blockIdx.x; F.vcu = (F.G % 8 == 0) ? (bx % 8) * (F.G / 8) + bx / 8 : bx; }
    XcdBarrier bar;
    {
        OPAQUE_TID(tid);
        for (int u = tid; u < (LDS_BYTES - LDSCTL_OFF) / 4; u += NWAVES * 64) ((LAS unsigned*)(F.lds + LDSCTL_OFF))[u] = 0u;
        __syncthreads();
        bar = xcd_barrier_post((unsigned*)(args.ws + WS_CTL) + CW_BAR, (volatile LAS unsigned*)(F.lds + MISC_OFF) + 8);
    }
#ifdef PROBE_PT
    if (blockIdx.x == 0 && threadIdx.x == 0) ((unsigned long long*)(args.ws + WS_CTL))[1024] = __builtin_amdgcn_s_memrealtime();
#define STAMP(k) do { if (blockIdx.x == 0 && threadIdx.x == 0) { unsigned long long* tp = (unsigned long long*)(args.ws + WS_CTL) + 1024; tp[2 + (k)] = __builtin_amdgcn_s_memrealtime(); if ((k) == PROBE_PT) { const unsigned long long d_ = tp[2 + (k)] - ((k) == 0 ? tp[0] : tp[1 + (k)]); tp[1] = (d_ / PROBE_Q) * PROBE_Q; } } } while (0)
#else
#define STAMP(k) do {} while (0)
#endif

    {
        KARGS(ap); unsigned char* ws = ap->ws; OPAQUE_TID(tid);
        const int lane = tid & 63, wave = __builtin_amdgcn_readfirstlane(tid >> 6), gw = F.vcu * NWAVES + wave, NGW = F.G * NWAVES;
        LAS float* scr = (LAS float*)(F.lds + RING_OFF + wave * 16384);
        constexpr int I_IN = (D / 64) * (INW / 32), I_A = (512 / 64) * (D / 32), I_O = (D / 64) * (D / 32), I_Q = (D / 64) * (2048 / 32);
        constexpr int NITEMS = I_IN + 2 * I_A + I_O + I_Q;
        for (int it = gw; it < NITEMS; it += NGW) {
            int r = it;
            if (r < I_IN) { p0_transpose_item(ap->in[2], D, INW, (bf16*)(ws + WS_WIN), 2, scr, r, lane); continue; } r -= I_IN;
            if (r < I_A) { p0_transpose_item(ap->in[6], 512, D, (bf16*)(ws + WS_WA), 1, scr, r, lane); continue; } r -= I_A;
            if (r < I_A) { p0_transpose_item(ap->in[7], 512, D, (bf16*)(ws + WS_WB), 1, scr, r, lane); continue; } r -= I_A;
            if (r < I_O) { p0_transpose_item(ap->in[8], D, D, (bf16*)(ws + WS_WOUT), 0, scr, r, lane); continue; } r -= I_O;
            p0_transpose_item(ap->in[10], D, 2048, (bf16*)(ws + WS_WQ), 1, scr, r, lane);
        }
        { const float* x = ap->in[0]; const float* g1 = ap->in[1]; bf16* Hb = (bf16*)(ws + WS_H);
          for (int m = gw; m < T; m += NGW) rms_row_to_bf16(lane, x + (size_t)m * D, g1, Hb + (size_t)m * D); }
        const size_t gtid = (size_t)F.vcu * 512 + tid, gth = (size_t)F.G * 512;
        for (int r = gw; r < 2 * NEXP; r += NGW) { const int tb = r >= NEXP, row = r - tb * NEXP;
            row_to_fp8(lane, (tb ? ap->in[13] : ap->in[12]) + (size_t)row * D, ws + (tb ? WS_V : WS_U) + (size_t)row * D, (float*)(ws + (tb ? WS_VS : WS_US)) + row); }
        cvt_stream(ap->in[11], (bf16*)(ws + WS_SUBK), (size_t)16 * 128 * 128 / 8, gtid, gth);
        if (gtid < 1024) { float* TAB = (float*)(ws + WS_TAB); const int pos = (int)gtid >> 4, f = (int)gtid & 15; const float ang = (float)pos * powf(10000.f, -(float)f / 16.f); TAB[gtid] = cosf(ang); TAB[1024 + gtid] = sinf(ang);
            if (gtid < 64) { TAB[2048 + gtid] = ap->in[4][gtid]; TAB[2048 + 64 + gtid] = ap->in[5][gtid]; } }
    }
    xcd_barrier(bar);
    STAMP(0);

    {
        KARGS(ap); unsigned char* ws = ap->ws;
        pg8::Gemm g{(const bf16*)(ws + WS_H), (const bf16*)(ws + WS_WIN), T, INW, D}; pg8::StaticOrder S; S.init(T, INW, F.G, (int)blockIdx.x);
        pg8::EpiProj E{PGG(unsigned char, ws)};
        pg8::gemm_phase<pg8::EpiProj, pg8::StaticOrder, true, true>(F.lds + RING_OFF, g, S, E);
    }
    xcd_barrier(bar);
    STAMP(1);

    {
        using namespace attn_body;
        for (int uid = F.vcu; uid < 1024; uid += F.G) {
            KARGS(ap); unsigned char* ws = ap->ws;
            if (uid < 512) {
                const int bh = uid >> 3, qb = uid & 7, b = bh >> 3, h = bh & 7, kvh = h >> 2;
                const attn_body::bf16* Qu = (const attn_body::bf16*)(ws + WS_QB) + ((size_t)b * SEQ + qb * 256) * 512 + h * 64;
                const attn_body::bf16* Kt = (const attn_body::bf16*)(ws + WS_KB) + ((size_t)b * SEQ) * 128 + kvh * 64;
                const attn_body::bf16* Vt = (const attn_body::bf16*)(ws + WS_VB) + ((size_t)b * SEQ) * 128 + kvh * 64;
                attn_unit<0, 8, 512, 128>(Qu, Kt, Vt, (attn_body::bf16*)Qu, 32, 0, 0, (char*)lds + RING_OFF);
            } else {
                const int v = uid - 512, bh = v >> 3, g = v & 7, b = bh >> 3, h = bh & 7;
                const int krow0 = (g == 0) ? 0 : (g == 7 ? 24 : 4 * g - 4), NT = (g == 0 || g == 7) ? 8 : 12;
                {
                    OPAQUE_TID(tid); const GAS float* rpb = (const GAS float*)ap->in[3];
                    __syncthreads();
                    for (int i = tid; i < 15 * 128; i += NWAVES * 64) { const int dr = i >> 7, xx = (i & 127) - 48;
                        ((LAS float*)(F.lds + RING_OFF + LDS_NATAB))[i] = (xx >= 0 && xx <= 30) ? rpb[(h * 15 + dr) * 31 + xx] * 1.4426950408889634f : 0.f; }
                    __syncthreads();
                }
                const attn_body::bf16* Qu = (const attn_body::bf16*)(ws + WS_QA) + ((size_t)b * SEQ + g * 256) * 512 + h * 64;
                const attn_body::bf16* Kt = (const attn_body::bf16*)(ws + WS_KA) + ((size_t)b * SEQ + krow0 * 64) * 512 + h * 64;
                const attn_body::bf16* Vt = (const attn_body::bf16*)(ws + WS_VA) + ((size_t)b * SEQ + krow0 * 64) * 512 + h * 64;
                attn_unit<1, 8, 512, 512>(Qu, Kt, Vt, (attn_body::bf16*)Qu, NT, 4 * g, krow0, (char*)lds + RING_OFF);
            }
        }
    }
    xcd_barrier(bar);
    STAMP(2);

    {
        KARGS(ap); unsigned char* ws = ap->ws;
        pg8::Gemm g{(const bf16*)(ws + WS_QA), (const bf16*)(ws + WS_WA), T, D, 512}; pg8::StaticOrder S; S.init(T, D, F.G, (int)blockIdx.x);
        pg8::EpiGate<0> E{PGG(const bf16, ws + WS_G), 0, PGG(bf16, ws + WS_MERGED)};
        pg8::gemm_phase<pg8::EpiGate<0>, pg8::StaticOrder, true, true>(F.lds + RING_OFF, g, S, E);
    }
    {
        KARGS(ap); unsigned char* ws = ap->ws;
        pg8::Gemm g{(const bf16*)(ws + WS_QB), (const bf16*)(ws + WS_WB), T, D, 512}; pg8::StaticOrder S; S.init(T, D, F.G, (int)blockIdx.x);
        pg8::EpiGate<1> E{PGG(const bf16, ws + WS_G), 1024, PGG(bf16, ws + WS_MERGED)};
        pg8::gemm_phase<pg8::EpiGate<1>, pg8::StaticOrder, true, true>(F.lds + RING_OFF, g, S, E);
    }
    xcd_barrier(bar);
    STAMP(3);

    {
        KARGS(ap); unsigned char* ws = ap->ws;
        pg8::Gemm g{(const bf16*)(ws + WS_MERGED), (const bf16*)(ws + WS_WOUT), T, D, D}; pg8::StaticOrder S; S.init(T, D, F.G, (int)blockIdx.x);
        pg8::EpiRes E{PGG(const float, ap->in[0]), PGG(float, ap->out)};
        pg8::gemm_phase<pg8::EpiRes, pg8::StaticOrder, true, true>(F.lds + RING_OFF, g, S, E);
    }
    xcd_barrier(bar);
    STAMP(4);

    {
        KARGS(ap); unsigned char* ws = ap->ws; OPAQUE_TID(tid);
        const int lane = tid & 63, gw = F.vcu * NWAVES + __builtin_amdgcn_readfirstlane(tid >> 6), NGW = F.G * NWAVES;
        const float* x1 = ap->out; const float* g2 = ap->in[9]; bf16* XN = (bf16*)(ws + WS_XN);
        for (int m = gw; m < T; m += NGW) rms_row_to_bf16(lane, x1 + (size_t)m * D, g2, XN + (size_t)m * D);
    }
    xcd_barrier(bar);
    STAMP(5);

    {
        KARGS(ap); unsigned char* ws = ap->ws;
        pg8::Gemm g{(const bf16*)(ws + WS_XN), (const bf16*)(ws + WS_WQ), T, 2048, D}; pg8::StaticOrder S; S.init(T, 2048, F.G, (int)blockIdx.x);
        pg8::EpiStore E{PGG(bf16, ws + WS_Q2), 2048};
        pg8::gemm_phase<pg8::EpiStore, pg8::StaticOrder, true, true>(F.lds + RING_OFF, g, S, E);
    }
    xcd_barrier(bar);
    STAMP(6);

    { KARGS(ap); route_phase(F, ap->ws); }
    xcd_barrier(bar);
    STAMP(7);

    { KARGS(ap); sort_phase(F, ap->ws); }
    xcd_barrier(bar);
    { KARGS(ap); act_phase(F, ap->ws, bar.x, bar.bar); }
    xcd_barrier(bar);
    { KARGS(ap); expert_phase(F, ap->ws, ap->in[14], ap->out); }
}

extern "C" void kernel_launch(void* const* d_in, const int* in_sizes, int n_in, void* d_out, int out_size, void* d_ws, size_t ws_size, hipStream_t stream) {
    static int grid = 0;
    if (grid == 0) {
        if (n_in != 15 || in_sizes[0] != T * D || out_size != T * D || ws_size < WS_END) { fprintf(stderr, "kernel_launch: unexpected shapes (n_in %d, in0 %d, out %d, ws %zu); nothing launched\n", n_in, n_in > 0 ? in_sizes[0] : -1, out_size, ws_size); grid = -1; return; }
        int dev = 0, cus = 0, per_cu = 0;
        if (hipGetDevice(&dev) != hipSuccess || hipDeviceGetAttribute(&cus, hipDeviceAttributeMultiprocessorCount, dev) != hipSuccess) { fprintf(stderr, "kernel_launch: device query failed\n"); grid = -1; return; }
        if (hipFuncSetAttribute((const void*)mk_fwd, hipFuncAttributeMaxDynamicSharedMemorySize, LDS_BYTES) != hipSuccess) { fprintf(stderr, "kernel_launch: hipFuncSetAttribute failed\n"); grid = -1; return; }
        if (hipOccupancyMaxActiveBlocksPerMultiprocessor(&per_cu, (const void*)mk_fwd, NWAVES * 64, LDS_BYTES) != hipSuccess || per_cu < 1) { fprintf(stderr, "kernel_launch: occupancy query reports %d workgroups per CU\n", per_cu); per_cu = 1; }
        (void)hipGetLastError();
        grid = cus;
        if (grid > 256) grid = 256;
    }
    if (grid < 0) return;
    if (hipMemsetAsync((char*)d_ws + WS_CTL, 0, CTL_ZERO_BYTES, stream) != hipSuccess) { fprintf(stderr, "kernel_launch: hipMemsetAsync failed\n"); return; }
    Args a{};
    for (int i = 0; i < 15; ++i) a.in[i] = (const float*)d_in[i];
    a.out = (float*)d_out; a.ws = (unsigned char*)d_ws;
    hipLaunchKernelGGL(mk_fwd, dim3(grid), dim3(NWAVES * 64), LDS_BYTES, stream, a);
    const hipError_t le = hipPeekAtLastError();
    if (le != hipSuccess) fprintf(stderr, "kernel_launch: launch failed: %s\n", hipGetErrorName(le));
}
```
